# Optimizing an MI355X kernel written in HIP

```python
import math
import jax, jax.numpy as jnp
from jax import lax
import numpy as np

D_MODEL = 1024
BATCH = 4
SEQ = 8192
DEPTH = 2

N_A = DEPTH // 2
N_B = DEPTH - N_A

CONV_CH = D_MODEL
CONV_W = 3

HEAD_DIM = 64
N_HEADS = D_MODEL // HEAD_DIM
N_KV_HEADS = 4
GROUP = N_HEADS // N_KV_HEADS
WINDOW = 128
BLOCK = 128
ROT_DIM = HEAD_DIM // 4
ROPE_THETA = 500000.0
EPS = 1e-6
NEG_INF = -1e30

kernel_name = "yoco_shortconv_swa_sink_hybrid"


def rmsnorm(x, g):
    xf = x.astype(jnp.float32)
    y = xf * lax.rsqrt(jnp.mean(xf * xf, axis=-1, keepdims=True) + EPS)
    return (y * g.astype(jnp.float32)).astype(x.dtype)


def rope_tables(seq):
    pos = jnp.arange(seq, dtype=jnp.float32)
    inv = ROPE_THETA ** (-jnp.arange(0, ROT_DIM, 2, dtype=jnp.float32) / ROT_DIM)
    ang = pos[:, None] * inv[None, :]
    return jnp.cos(ang), jnp.sin(ang)


def partial_rope(t, cos, sin):
    tf = t.astype(jnp.float32)
    rot, rest = tf[..., :ROT_DIM], tf[..., ROT_DIM:]
    r1, r2 = rot[..., : ROT_DIM // 2], rot[..., ROT_DIM // 2:]
    c = cos[None, :, None, :]
    s = sin[None, :, None, :]
    out = jnp.concatenate([r1 * c - r2 * s, r2 * c + r1 * s, rest], axis=-1)
    return out.astype(t.dtype)


def short_conv_mixer(x, ln_g, w_in, conv_w, w_out):
    h = rmsnorm(x, ln_g)
    b_gate, c_gate, u, z = jnp.split(h @ w_in, 4, axis=-1)
    v = c_gate * u
    conv = lax.conv_general_dilated(
        v, conv_w.astype(v.dtype), window_strides=(1,), padding=[(CONV_W - 1, 0)],
        dimension_numbers=("NWC", "WIO", "NWC"), feature_group_count=CONV_CH)
    y = b_gate * conv * jax.nn.silu(z)
    return y @ w_out


def shared_kv(x, ln_g, w_kv, k_norm_g, cos, sin):
    bsz, seq, _ = x.shape
    nb = seq // BLOCK
    h = rmsnorm(x, ln_g)
    k, v = jnp.split(h @ w_kv, 2, axis=-1)
    k = k.reshape(bsz, seq, N_KV_HEADS, HEAD_DIM)
    v = v.reshape(bsz, seq, N_KV_HEADS, HEAD_DIM)
    k = partial_rope(rmsnorm(k, k_norm_g), cos, sin)

    def band(t):
        tb = t.reshape(bsz, nb, BLOCK, N_KV_HEADS, HEAD_DIM)
        prev = jnp.concatenate([jnp.zeros_like(tb[:, :1]), tb[:, :-1]], axis=1)
        tb = jnp.concatenate([prev, tb], axis=2)
        return jnp.moveaxis(tb, 1, 0)

    return band(k), band(v)


def swa_sink_mixer(x, ln_g, w_in, q_norm_g, sinks, w_out, k_band, v_band, cos, sin):
    bsz, seq, _ = x.shape
    nb = seq // BLOCK
    h = rmsnorm(x, ln_g)
    q, z = jnp.split(h @ w_in, 2, axis=-1)
    q = q.reshape(bsz, seq, N_HEADS, HEAD_DIM)
    q = partial_rope(rmsnorm(q, q_norm_g), cos, sin)
    q = q.reshape(bsz, nb, BLOCK, N_KV_HEADS, GROUP, HEAD_DIM)
    q = jnp.moveaxis(q, 1, 0)

    scale = 1.0 / math.sqrt(HEAD_DIM)
    a_idx = jnp.arange(BLOCK)[:, None]
    c_idx = jnp.arange(2 * BLOCK)[None, :]
    rel_ok = (c_idx <= a_idx + BLOCK) & (c_idx > a_idx + BLOCK - WINDOW)
    sink = sinks.astype(jnp.float32).reshape(N_KV_HEADS, GROUP)[None, :, :, None, None]

    def block_attn(args):
        qb, kb, vb, blk = args
        s = jnp.einsum("bqkgd,bckd->bkgqc", qb.astype(jnp.float32),
                       kb.astype(jnp.float32)) * scale
        mask = rel_ok & ((blk > 0) | (c_idx >= BLOCK))
        s = jnp.where(mask[None, None, None], s, NEG_INF)
        m = jnp.maximum(jnp.max(s, axis=-1, keepdims=True), sink)
        p = jnp.exp(s - m)
        denom = jnp.sum(p, axis=-1, keepdims=True) + jnp.exp(sink - m)
        o = jnp.einsum("bkgqc,bckd->bqkgd", p / denom, vb.astype(jnp.float32))
        return o.astype(x.dtype)

    o = lax.map(block_attn, (q, k_band, v_band, jnp.arange(nb)))
    o = jnp.moveaxis(o, 0, 1).reshape(bsz, seq, N_HEADS * HEAD_DIM)
    return (o * jax.nn.silu(z)) @ w_out


def setup_inputs(seed: int = 0) -> dict:
    key = jax.random.key(seed)
    ks = jax.random.split(key, 16)
    f32 = jnp.float32
    D, W, H, KV, HD = D_MODEL, CONV_CH, N_HEADS, N_KV_HEADS, HEAD_DIM
    nrm = lambda k, shape, fan: jax.random.normal(k, shape, f32) * (fan ** -0.5)
    return {
        "x": jax.random.normal(ks[0], (BATCH, SEQ, D), f32),
        "ln_a": 1.0 + 0.02 * jax.random.normal(ks[1], (N_A, D), f32),
        "w_in_a": nrm(ks[2], (N_A, D, 4 * W), D),
        "conv_a": nrm(ks[3], (N_A, CONV_W, 1, W), CONV_W),
        "w_out_a": nrm(ks[4], (N_A, W, D), W),
        "ln_kv": 1.0 + 0.02 * jax.random.normal(ks[5], (D,), f32),
        "w_kv": nrm(ks[6], (D, 2 * KV * HD), D),
        "k_norm": 1.0 + 0.02 * jax.random.normal(ks[7], (HD,), f32),
        "ln_b": 1.0 + 0.02 * jax.random.normal(ks[8], (N_B, D), f32),
        "w_in_b": nrm(ks[9], (N_B, D, 2 * H * HD), D),
        "q_norm": 1.0 + 0.02 * jax.random.normal(ks[10], (N_B, HD), f32),
        "sinks": 0.5 * jax.random.normal(ks[11], (N_B, H), f32),
        "w_out_b": nrm(ks[12], (N_B, H * HD, D), H * HD),
    }


def reference(x, ln_a, w_in_a, conv_a, w_out_a, ln_kv, w_kv, k_norm,
              ln_b, w_in_b, q_norm, sinks, w_out_b):
    seq = x.shape[1]
    cos, sin = rope_tables(seq)
    k_band = v_band = None
    for layer in range(DEPTH):
        if layer < N_A:
            i = layer
            x = x + short_conv_mixer(x, ln_a[i], w_in_a[i], conv_a[i], w_out_a[i])
        else:
            i = layer - N_A
            if i == 0:
                k_band, v_band = shared_kv(x, ln_kv, w_kv, k_norm, cos, sin)
            x = x + swa_sink_mixer(x, ln_b[i], w_in_b[i], q_norm[i], sinks[i], w_out_b[i],
                                   k_band, v_band, cos, sin)
    return x
```

```cpp
#include <hip/hip_runtime.h>
#include <hip/hip_cooperative_groups.h>
#include <cstdio>
#include <cmath>
namespace cg = cooperative_groups;

#ifndef MEGA
#define MEGA 1
#endif

#define LAS __attribute__((address_space(3)))
typedef unsigned short bf16_t;
typedef short bf16x8 __attribute__((ext_vector_type(8)));
typedef float f32x4 __attribute__((ext_vector_type(4)));
typedef float f32x16 __attribute__((ext_vector_type(16)));
typedef unsigned u32x4 __attribute__((ext_vector_type(4)));
typedef unsigned u32x2 __attribute__((ext_vector_type(2)));

constexpr int M_ = 32768, D_ = 1024, SEQ_ = 8192;
constexpr float EPS_ = 1e-6f;
constexpr int BM = 256, BK = 64, HALF = 128, HTB = HALF * BK * 2, STAGE_BYTES = 8 * HTB, NXCD = 8, WGM = 8;
constexpr int HALO_OFF = STAGE_BYTES;
constexpr int RSTD_OFF = STAGE_BYTES + 2048;
constexpr int XBST_OFF = STAGE_BYTES + 2048 + 8192;
constexpr int ROPER_OFF = XBST_OFF + 64;
constexpr int GAIN_OFF = ROPER_OFF + 16384;
constexpr int LDS_BYTES = GAIN_OFF + 512;

constexpr size_t MB = 1024 * 1024;
constexpr size_t WS_R0 = 256 * MB;
constexpr size_t WS_R1 = 64 * MB;
constexpr size_t WS_ZB = 128 * MB;
constexpr size_t WS_KB = 192 * MB;
constexpr size_t WS_VB = 208 * MB;
constexpr size_t WS_WT = 224 * MB;
constexpr size_t WS_SSQ = 242 * MB;
constexpr size_t WS_ROPE = 245 * MB;
constexpr size_t WS_VL = 246 * MB;
constexpr size_t WS_G = 247 * MB;
constexpr size_t WS_YP = 248 * MB;
constexpr size_t WS_OG = WS_R1;
constexpr size_t WS_BAR = 320 * MB;
constexpr size_t WS_RSTD0 = 321 * MB;
constexpr size_t WS_END = 322 * MB;
constexpr int WROW1 = 0, WROW2 = 4096, WROW3 = 5120, WROW4 = 7680, WROWS = 8704;

struct Args {
    const float* x; const float* ln_a; const float* w_in_a; const float* conv_a; const float* w_out_a;
    const float* ln_kv; const float* w_kv; const float* k_norm; const float* ln_b; const float* w_in_b;
    const float* q_norm; const float* sinks; const float* w_out_b;
    float* out; unsigned char* ws;
    float inv0, inv1, inv2, inv3, inv4, inv5, inv6, inv7;
    int lo, hi;
};

typedef float f32x2_t __attribute__((ext_vector_type(2)));
typedef __bf16 bf16x2_t __attribute__((ext_vector_type(2)));
__device__ __forceinline__ unsigned cvt_pk_bf16(float lo, float hi) { const f32x2_t v = {lo, hi}; return __builtin_bit_cast(unsigned, __builtin_convertvector(v, bf16x2_t)); }
__device__ __forceinline__ bf16_t f2bf(float f) { unsigned u = __float_as_uint(f); u += 0x7FFFu + ((u >> 16) & 1u); return (bf16_t)(u >> 16); }
__device__ __forceinline__ float bf2f(unsigned short b) { return __uint_as_float(((unsigned)b) << 16); }
__device__ __forceinline__ float silu_f(float z) { return z * __builtin_amdgcn_rcpf(1.0f + __expf(-z)); }

__host__ __device__ __forceinline__ int lds_byte(int r, int c) { const int st = (r >> 4) * 2 + (c >> 5), rr = r & 15, cc = c & 31, ob = rr * 64 + cc * 2; return st * 1024 + (ob ^ (((ob >> 9) & 1) << 5)); }
__host__ __device__ __forceinline__ void stage_rc(int b, int& R, int& C) { const int st = b / 1024, sb = b % 1024, swz = sb ^ (((sb >> 9) & 1) << 5); R = (st >> 1) * 16 + swz / 64; C = (st & 1) * 32 + (swz % 64) / 2; }

__host__ __device__ __forceinline__ int perm32(int rho) { const int n = rho >> 4, i = rho & 15; return 8 * (i >> 2) + 4 * n + (i & 3); }
struct Unit { int pm, pn; };
struct Gemm { const bf16_t* A; const bf16_t* Bt; int M, N, K; };
struct StaticOrder {
    int nM, nN, nwg, G, c;
    __device__ void init(int M, int N, int G_, int c_) { nM = M / BM; nN = N / BM; nwg = nM * nN; G = G_; c = c_; }
    __device__ bool next(int i, Unit& u) const {
        const long L = (long)i * G + c; if (L >= nwg) return false;
        int wgid = (int)L; { const int q = nwg / NXCD, r = nwg % NXCD, xcd = wgid % NXCD, off = wgid / NXCD; wgid = (xcd < r ? xcd * (q + 1) : r * (q + 1) + (xcd - r) * q) + off; }
        const int nig = WGM * nN, gid = wgid / nig, fm = gid * WGM, gsz = (nM - fm) < WGM ? (nM - fm) : WGM;
        u.pm = fm + ((wgid % nig) % gsz); u.pn = (wgid % nig) / gsz; return true;
    }
};

template <class Epi>
__device__ __forceinline__ void gemm_phase(LAS unsigned char* lds, const Gemm g, const StaticOrder& S, const Epi& E) {
    const int tid = threadIdx.x, wid = __builtin_amdgcn_readfirstlane(tid >> 6), lane = tid & 63, wr = wid >> 2, wc = wid & 3, fr = lane & 15, fq = lane >> 4;
    const int K = g.K, nt = K / BK;
    unsigned voffA[2], voffB[2];
#pragma unroll
    for (int i = 0; i < 2; ++i) { int R, C; stage_rc(tid * 16 + i * 8192, R, C); const int Rb = Epi::PERM ? ((R & ~31) + perm32(R & 31)) : R;
        const int Ra = Epi::AMAP ? (128 * (R >> 6) + (R & 63)) : R;
        voffA[i] = (unsigned)(Ra * K + C) * 2u; voffB[i] = (unsigned)(Rb * K + C) * 2u; }
    const size_t kstep = (size_t)(BK * 2);
    const size_t hstep = (size_t)HALF * K * 2;
    const size_t hstepA = Epi::AMAP ? (size_t)64 * K * 2 : hstep;
    const size_t tstep = 2 * hstep;
    const unsigned ldsw = (unsigned)wid * 1024u;
    const int aoff = lds_byte(wr * 64 + fr, fq * 8), boff = lds_byte(wc * 32 + fr, fq * 8);
#define PG8_SA(b, h) (((b) * 2 + (h)) * HTB)
#define PG8_SB(b, h) ((4 + (b) * 2 + (h)) * HTB)
#define PG8_STAGE(bufoff, gbase, voff) do { _Pragma("unroll") for (int _i = 0; _i < 2; ++_i) \
        __builtin_amdgcn_global_load_lds((const unsigned*)((const char*)(gbase) + (voff)[_i]), (LAS unsigned*)(lds + (bufoff) + ldsw + _i * 8192), 16, 0, 0); } while (0)
#define PG8_LDA(dst, b, h) do { _Pragma("unroll") for (int m = 0; m < 4; ++m) _Pragma("unroll") for (int k = 0; k < 2; ++k) dst[m][k] = *(const LAS bf16x8*)(lds + PG8_SA(b, h) + aoff + m * 2048 + k * 1024); } while (0)
#define PG8_LDB(dst, b, h) do { _Pragma("unroll") for (int n = 0; n < 2; ++n) _Pragma("unroll") for (int k = 0; k < 2; ++k) dst[n][k] = *(const LAS bf16x8*)(lds + PG8_SB(b, h) + boff + n * 2048 + k * 1024); } while (0)
#define PG8_MMA(ai, bj, At, Bt) do { __builtin_amdgcn_s_setprio(1); _Pragma("unroll") for (int m = 0; m < 4; ++m) _Pragma("unroll") for (int n = 0; n < 2; ++n) _Pragma("unroll") for (int k = 0; k < 2; ++k) \
        acc[ai][bj][m][n] = __builtin_amdgcn_mfma_f32_16x16x32_bf16(Bt[n][k], At[m][k], acc[ai][bj][m][n], 0, 0, 0); __builtin_amdgcn_s_setprio(0); } while (0)
#define PG8_WAIT_V(n) asm volatile("s_waitcnt vmcnt(" #n ")" ::: "memory")
#define PG8_WAIT_L(n) asm volatile("s_waitcnt lgkmcnt(" #n ")" ::: "memory")
#define PG8_BAR __builtin_amdgcn_s_barrier()
#define PG8_SCHED __builtin_amdgcn_sched_barrier(0)
    Unit cur, nxt; int ui = 0;
    if (!S.next(0, cur)) return;
    f32x4 acc[2][2][4][2];
#pragma unroll
    for (int a = 0; a < 2; ++a)
#pragma unroll
        for (int b = 0; b < 2; ++b)
#pragma unroll
            for (int m = 0; m < 4; ++m)
#pragma unroll
                for (int n = 0; n < 2; ++n) acc[a][b][m][n] = (f32x4){0.f, 0.f, 0.f, 0.f};
    bf16x8 At[4][2], B0[2][2], B1[2][2];
    const char* cA = (const char*)g.A + (size_t)cur.pm * tstep; const char* cB = (const char*)g.Bt + (size_t)cur.pn * tstep;
    PG8_STAGE(PG8_SB(0, 0), cB, voffB); PG8_STAGE(PG8_SB(0, 1), cB + hstep, voffB); PG8_STAGE(PG8_SA(0, 0), cA, voffA); PG8_STAGE(PG8_SA(0, 1), cA + hstepA, voffA);
    if (wr == 1) PG8_BAR;
    PG8_WAIT_V(2); PG8_BAR;
    PG8_STAGE(PG8_SB(1, 0), cB + kstep, voffB); PG8_STAGE(PG8_SA(1, 0), cA + kstep, voffA); PG8_STAGE(PG8_SB(1, 1), cB + hstep + kstep, voffB);
    PG8_WAIT_V(6); PG8_BAR;
    for (;;) {
        const bool has_next = S.next(ui + 1, nxt);
        const char* nA = has_next ? (const char*)g.A + (size_t)nxt.pm * tstep : cA; const char* nB = has_next ? (const char*)g.Bt + (size_t)nxt.pn * tstep : cB;
        for (int t = 0; t < nt; t += 2) {
            const bool last = (t == nt - 2);
            const char* a1 = cA + (size_t)(t + 1) * kstep;
            const char* a2 = last ? nA : cA + (size_t)(t + 2) * kstep; const char* b2 = last ? nB : cB + (size_t)(t + 2) * kstep;
            const char* a3 = a2 + kstep; const char* b3 = b2 + kstep;
            PG8_LDB(B0, 0, 0); PG8_LDB(B1, 0, 1); PG8_SCHED; PG8_LDA(At, 0, 0); PG8_STAGE(PG8_SA(1, 1), a1 + hstepA, voffA);
            PG8_WAIT_V(8); PG8_WAIT_L(0); PG8_BAR; PG8_MMA(0, 0, At, B0); PG8_MMA(0, 1, At, B1); PG8_BAR; PG8_SCHED;
            PG8_LDA(At, 0, 1); PG8_STAGE(PG8_SB(0, 0), b2, voffB); PG8_STAGE(PG8_SB(0, 1), b2 + hstep, voffB); PG8_STAGE(PG8_SA(0, 0), a2, voffA);
            PG8_WAIT_V(8); PG8_WAIT_L(0); PG8_BAR; PG8_MMA(1, 0, At, B0); PG8_MMA(1, 1, At, B1); PG8_BAR; PG8_SCHED;
            PG8_LDB(B0, 1, 0); PG8_LDB(B1, 1, 1); PG8_SCHED; PG8_LDA(At, 1, 0); PG8_STAGE(PG8_SA(0, 1), a2 + hstepA, voffA);
            PG8_WAIT_V(8); PG8_WAIT_L(0); PG8_BAR; PG8_MMA(0, 0, At, B0); PG8_MMA(0, 1, At, B1); PG8_BAR; PG8_SCHED;
            PG8_LDA(At, 1, 1); PG8_STAGE(PG8_SB(1, 0), b3, voffB); PG8_STAGE(PG8_SB(1, 1), b3 + hstep, voffB); PG8_STAGE(PG8_SA(1, 0), a3, voffA);
            PG8_WAIT_V(8); PG8_WAIT_L(0); PG8_BAR; PG8_MMA(1, 0, At, B0); PG8_MMA(1, 1, At, B1); PG8_BAR; PG8_SCHED;
        }
        if (wr == 0) PG8_BAR;
        E(acc, cur, ui, wr, wc, fr, fq);
        if (!has_next) break;
#pragma unroll
        for (int a = 0; a < 2; ++a)
#pragma unroll
            for (int b = 0; b < 2; ++b)
#pragma unroll
                for (int m = 0; m < 4; ++m)
#pragma unroll
                    for (int n = 0; n < 2; ++n) acc[a][b][m][n] = (f32x4){0.f, 0.f, 0.f, 0.f};
        cur = nxt; cA = nA; cB = nB; ++ui;
        if (wr == 1) PG8_BAR;
    }
    PG8_WAIT_V(0);
    PG8_BAR;
#undef PG8_SA
#undef PG8_SB
#undef PG8_STAGE
#undef PG8_LDA
#undef PG8_LDB
#undef PG8_MMA
#undef PG8_WAIT_V
#undef PG8_WAIT_L
#undef PG8_BAR
#undef PG8_SCHED
}

__device__ __forceinline__ void st_bf16x4(bf16_t* p, const f32x4 v) { u32x2 w; w.x = cvt_pk_bf16(v[0], v[1]); w.y = cvt_pk_bf16(v[2], v[3]); *(u32x2*)p = w; }

__device__ __forceinline__ float dpp_ror1(float v) { return __builtin_bit_cast(float, __builtin_amdgcn_update_dpp(0, __builtin_bit_cast(int, v), 0x121, 0xf, 0xf, false)); }
__device__ __forceinline__ float dpp_ror2(float v) { return __builtin_bit_cast(float, __builtin_amdgcn_update_dpp(0, __builtin_bit_cast(int, v), 0x122, 0xf, 0xf, false)); }
struct Epi1 {
    static constexpr bool PERM = false, AMAP = true;
    bf16_t* Y; const float* convw; float* VL; float* G; float* YP; LAS float* hal;
    __device__ __forceinline__ void operator()(f32x4 (&acc)[2][2][4][2], const Unit& u, int ui, int wr, int wc, int fr, int fq) const {
        const int ch = u.pn * 64 + wc * 16 + 8 * (fq & 1) + 4 * (fq >> 1);
        const f32x4 w0 = *(const f32x4*)(convw + ch), w1 = *(const f32x4*)(convw + 1024 + ch), w2 = *(const f32x4*)(convw + 2048 + ch);
#pragma unroll
        for (int ai = 0; ai < 2; ++ai)
#pragma unroll
            for (int m = 0; m < 4; ++m) {
                const f32x4 Bv = acc[ai][0][m][0], Cv = acc[ai][0][m][1], Uv = acc[ai][1][m][0], Zv = acc[ai][1][m][1];
                f32x4 gt, v;
#pragma unroll
                for (int j = 0; j < 4; ++j) { gt[j] = Bv[j] * silu_f(Zv[j]); v[j] = Cv[j] * Uv[j]; }
                acc[ai][0][m][0] = gt; acc[ai][0][m][1] = v;
            }
        LAS float* hp = hal + (fr & 1) * 64 + wc * 16 + fq * 4;
        f32x4 vprev = (f32x4){0.f, 0.f, 0.f, 0.f};
        if (wr == 0 && fr >= 14) *(LAS f32x4*)hp = acc[1][0][3][1];
        asm volatile("s_waitcnt lgkmcnt(0)" ::: "memory"); __builtin_amdgcn_s_barrier(); asm volatile("" ::: "memory");
        if (wr == 1 && fr >= 14) vprev = *(const LAS f32x4*)hp;
#pragma unroll
        for (int ai = 0; ai < 2; ++ai)
#pragma unroll
            for (int mp = 0; mp < 2; ++mp) {
                unsigned yp[2][2];
#pragma unroll
                for (int mm = 0; mm < 2; ++mm) {
                    const int m = 2 * mp + mm;
                    const f32x4 vc = acc[ai][0][m][1], gt = acc[ai][0][m][0];
                    f32x4 y;
#pragma unroll
                    for (int j = 0; j < 4; ++j) {
                        const float c1 = (fr == 15) ? vprev[j] : vc[j], c2 = (fr >= 14) ? vprev[j] : vc[j];
                        const float vm1 = dpp_ror1(c1), vm2 = dpp_ror2(c2);
                        y[j] = gt[j] * (w0[j] * vm2 + w1[j] * vm1 + w2[j] * vc[j]);
                    }
                    yp[mm][0] = cvt_pk_bf16(y[0], y[1]); yp[mm][1] = cvt_pk_bf16(y[2], y[3]);
                    if (wr == 0 && ai == 0 && m == 0 && fr < 2) { *(f32x4*)(G + (size_t)(u.pm * 2 + fr) * D_ + ch) = gt; *(f32x4*)(YP + (size_t)(u.pm * 2 + fr) * D_ + ch) = y; }
                    if (wr == 1 && ai == 1 && m == 3 && fr >= 14) *(f32x4*)(VL + (size_t)(u.pm * 2 + fr - 14) * D_ + ch) = vc;
                    vprev = vc;
                }
                { auto r0 = __builtin_amdgcn_permlane32_swap(yp[0][0], yp[1][0], false, false); auto r1 = __builtin_amdgcn_permlane32_swap(yp[0][1], yp[1][1], false, false);
                  const int row = u.pm * BM + wr * HALF + ai * 64 + (2 * mp + (fq >> 1)) * 16 + fr;
                  *(u32x4*)(Y + (size_t)row * D_ + u.pn * 64 + wc * 16 + 8 * (fq & 1)) = (u32x4){r0[0], r1[0], r0[1], r1[1]}; }
            }
    }
};
__device__ __forceinline__ void st_bf16x8(bf16_t* p, const f32x4 v0, const f32x4 v1) { u32x4 w; w.x = cvt_pk_bf16(v0[0], v0[1]); w.y = cvt_pk_bf16(v0[2], v0[3]); w.z = cvt_pk_bf16(v1[0], v1[1]); w.w = cvt_pk_bf16(v1[2], v1[3]); *(u32x4*)p = w; }
struct Epi2 {
    static constexpr bool PERM = true, AMAP = false;
    bf16_t* HX; float* SSQ; const LAS float* irs_tab; const LAS float* invg;
    __device__ __forceinline__ void operator()(f32x4 (&acc)[2][2][4][2], const Unit& u, int ui, int wr, int wc, int fr, int fq) const {
        const int rl0 = wr * 64 + fr, row0 = u.pm * BM + rl0, col0 = u.pn * BM + wc * 32 + 8 * fq;
        f32x4 ig[2][2];
#pragma unroll
        for (int bj = 0; bj < 2; ++bj)
#pragma unroll
            for (int n = 0; n < 2; ++n) ig[bj][n] = *(const LAS f32x4*)(invg + col0 + bj * HALF + 4 * n);
        {
            u32x4 hb[16];
#define EPI2_LOAD(k) hb[k] = *(const u32x4*)(HX + (size_t)(row0 + ((k) >> 3) * HALF + (((k) >> 1) & 3) * 16) * D_ + col0 + ((k) & 1) * HALF)
#pragma unroll
            for (int k = 0; k < 8; ++k) EPI2_LOAD(k);
#pragma unroll
            for (int k = 0; k < 16; ++k) {
                if (k + 8 < 16) EPI2_LOAD(k + 8);
                const int ai = k >> 3, m = (k >> 1) & 3, bj = k & 1;
                const float irs = irs_tab[ui * 256 + rl0 + ai * HALF + m * 16];
                const u32x4 w = hb[k];
                const f32x4 h0 = (f32x4){__uint_as_float(w.x << 16), __uint_as_float(w.x & 0xffff0000u), __uint_as_float(w.y << 16), __uint_as_float(w.y & 0xffff0000u)};
                const f32x4 h1 = (f32x4){__uint_as_float(w.z << 16), __uint_as_float(w.z & 0xffff0000u), __uint_as_float(w.w << 16), __uint_as_float(w.w & 0xffff0000u)};
                acc[ai][bj][m][0] += h0 * ig[bj][0] * irs; acc[ai][bj][m][1] += h1 * ig[bj][1] * irs;
                asm volatile("" : "+v"(acc[ai][bj][m][0]), "+v"(acc[ai][bj][m][1]));
                __builtin_amdgcn_sched_barrier(0);
            }
#undef EPI2_LOAD
            asm volatile("" ::: "memory"); __builtin_amdgcn_sched_barrier(0);
        }
#pragma unroll
        for (int ai = 0; ai < 2; ++ai)
#pragma unroll
            for (int m = 0; m < 4; ++m) {
                const int row = row0 + ai * HALF + m * 16; float ss = 0.f;
#pragma unroll
                for (int bj = 0; bj < 2; ++bj) {
                    const f32x4 o0 = acc[ai][bj][m][0], o1 = acc[ai][bj][m][1];
                    st_bf16x8(HX + (size_t)row * D_ + col0 + bj * HALF, o0, o1);
                    ss += ((o0[0] * o0[0] + o0[1] * o0[1]) + (o0[2] * o0[2] + o0[3] * o0[3])) + ((o1[0] * o1[0] + o1[1] * o1[1]) + (o1[2] * o1[2] + o1[3] * o1[3]));
                }
                ss += __shfl_xor(ss, 16); ss += __shfl_xor(ss, 32);
                if (fq == 0) SSQ[(size_t)row * 16 + u.pn * 4 + wc] = ss;
            }
    }
};
struct Epi3 {
    static constexpr bool PERM = true, AMAP = false;
    const LAS float* rstd_tab; const LAS float* ropeR; const LAS float* gains; const float* ropeB; bf16_t* KB; bf16_t* VB; bf16_t* QB; bf16_t* ZB;
    __device__ __forceinline__ void operator()(f32x4 (&acc)[2][2][4][2], const Unit& u, int ui, int wr, int wc, int fr, int fq) const {
        const int pn = u.pn;
        const bool isk = (pn == 0), isq = (pn >= 2 && pn < 6);
        const int rl0 = wr * 64 + fr;
        if (isk || isq) {
            const LAS float* gp = gains + (isk ? 0 : 64);
            f32x4 gn[2][2];
#pragma unroll
            for (int bj = 0; bj < 2; ++bj)
#pragma unroll
                for (int n = 0; n < 2; ++n) gn[bj][n] = *(const LAS f32x4*)(gp + 32 * bj + 8 * fq + 4 * n);
            const float* rb = ropeB + (u.pm & 31) * 16;
            f32x4 cB[2], sB[2];
#pragma unroll
            for (int n = 0; n < 2; ++n) { cB[n] = *(const f32x4*)(rb + 4 * n); sB[n] = *(const f32x4*)(rb + 8 + 4 * n); }
            bf16_t* dst0; int ld;
            if (isk) { dst0 = KB + wc * 64; ld = 256; } else { dst0 = QB + (pn - 2) * 256 + wc * 64; ld = D_; }
#pragma unroll
            for (int ai = 0; ai < 2; ++ai)
#pragma unroll
                for (int m = 0; m < 4; ++m) {
                    const int rl = rl0 + ai * HALF + m * 16;
                    const float rstd = rstd_tab[ui * 256 + rl];
                    f32x4 v[2][2]; float ss = 0.f;
#pragma unroll
                    for (int bj = 0; bj < 2; ++bj)
#pragma unroll
                        for (int n = 0; n < 2; ++n) { v[bj][n] = acc[ai][bj][m][n] * rstd; ss += (v[bj][n][0] * v[bj][n][0] + v[bj][n][1] * v[bj][n][1]) + (v[bj][n][2] * v[bj][n][2] + v[bj][n][3] * v[bj][n][3]); }
                    ss += __shfl_xor(ss, 16); ss += __shfl_xor(ss, 32);
                    float rs = rsqrtf(ss * (1.0f / 64.0f) + EPS_);
                    if (isq) rs *= 0.18033688011112042f;
#pragma unroll
                    for (int bj = 0; bj < 2; ++bj)
#pragma unroll
                        for (int n = 0; n < 2; ++n) v[bj][n] = v[bj][n] * rs * gn[bj][n];
#pragma unroll
                    for (int n = 0; n < 2; ++n) {
                        const f32x4 cA = *(const LAS f32x4*)(ropeR + rl * 16 + 4 * n), sA = *(const LAS f32x4*)(ropeR + rl * 16 + 8 + 4 * n);
                        const f32x4 cs = cA * cB[n] - sA * sB[n], sn = sA * cB[n] + cA * sB[n];
#pragma unroll
                        for (int j = 0; j < 4; ++j) {
                            const float me = v[0][n][j], pr = __shfl_xor(me, 16);
                            const float ro = (fq == 0) ? (me * cs[j] - pr * sn[j]) : (me * cs[j] + pr * sn[j]);
                            v[0][n][j] = (fq < 2) ? ro : me;
                        }
                    }
                    bf16_t* dst = dst0 + (size_t)(u.pm * BM + rl) * ld + 8 * fq;
#pragma unroll
                    for (int bj = 0; bj < 2; ++bj) st_bf16x8(dst + 32 * bj, v[bj][0], v[bj][1]);
                }
        } else {
            bf16_t* dst0; int ld;
            if (pn == 1) { dst0 = VB + wc * 64; ld = 256; } else { dst0 = ZB + (pn - 6) * 256 + wc * 64; ld = D_; }
            const bool act = (pn != 1);
#pragma unroll
            for (int ai = 0; ai < 2; ++ai)
#pragma unroll
                for (int m = 0; m < 4; ++m) {
                    const float rstd = rstd_tab[ui * 256 + rl0 + ai * HALF + m * 16];
                    bf16_t* dst = dst0 + (size_t)(u.pm * BM + rl0 + ai * HALF + m * 16) * ld + 8 * fq;
#pragma unroll
                    for (int bj = 0; bj < 2; ++bj) {
                        f32x4 v0 = acc[ai][bj][m][0] * rstd, v1 = acc[ai][bj][m][1] * rstd;
                        if (act) {
#pragma unroll
                            for (int j = 0; j < 4; ++j) { v0[j] = silu_f(v0[j]); v1[j] = silu_f(v1[j]); }
                        }
                        st_bf16x8(dst + 32 * bj, v0, v1);
                    }
                }
        }
    }
};
struct Epi4 {
    static constexpr bool PERM = true, AMAP = false;
    const bf16_t* X1B; float* O;
    __device__ __forceinline__ void operator()(f32x4 (&acc)[2][2][4][2], const Unit& u, int ui, int wr, int wc, int fr, int fq) const {
        const int row0 = u.pm * BM + wr * 64 + fr, col0 = u.pn * BM + wc * 32 + 8 * fq;
        {
            u32x4 xb[2][4][2];
#pragma unroll
            for (int ai = 0; ai < 2; ++ai)
#pragma unroll
                for (int m = 0; m < 4; ++m)
#pragma unroll
                    for (int bj = 0; bj < 2; ++bj) xb[ai][m][bj] = *(const u32x4*)(X1B + (size_t)(row0 + ai * HALF + m * 16) * D_ + col0 + bj * HALF);
#pragma unroll
            for (int ai = 0; ai < 2; ++ai)
#pragma unroll
                for (int m = 0; m < 4; ++m)
#pragma unroll
                    for (int bj = 0; bj < 2; ++bj) {
                        const u32x4 w = xb[ai][m][bj];
                        acc[ai][bj][m][0] += (f32x4){__uint_as_float(w.x << 16), __uint_as_float(w.x & 0xffff0000u), __uint_as_float(w.y << 16), __uint_as_float(w.y & 0xffff0000u)};
                        acc[ai][bj][m][1] += (f32x4){__uint_as_float(w.z << 16), __uint_as_float(w.z & 0xffff0000u), __uint_as_float(w.w << 16), __uint_as_float(w.w & 0xffff0000u)};
                        asm volatile("" : "+v"(acc[ai][bj][m][0]), "+v"(acc[ai][bj][m][1]));
                    }
            asm volatile("" ::: "memory"); __builtin_amdgcn_sched_barrier(0);
        }
#pragma unroll
        for (int ai = 0; ai < 2; ++ai)
#pragma unroll
            for (int m = 0; m < 4; ++m)
#pragma unroll
                for (int bj = 0; bj < 2; ++bj) {
                    float* p = O + (size_t)(row0 + ai * HALF + m * 16) * D_ + col0 + bj * HALF;
                    *(f32x4*)p = acc[ai][bj][m][0]; *(f32x4*)(p + 4) = acc[ai][bj][m][1];
                }
    }
};

__device__ __forceinline__ void sincos_d(double a, float& c, float& s) {
    const double q = rint(a * 0.63661977236758134308);
    double r = fma(-q, 1.57079632679489655800, a); r = fma(-q, 6.12323399573676603587e-17, r);
    const double r2 = r * r;
    double sp = -7.6471637318198164759e-13; sp = fma(sp, r2, 1.6059043836821614599e-10); sp = fma(sp, r2, -2.5052108385441718775e-8); sp = fma(sp, r2, 2.7557319223985890653e-6);
    sp = fma(sp, r2, -1.9841269841269841270e-4); sp = fma(sp, r2, 8.3333333333333333333e-3); sp = fma(sp, r2, -1.6666666666666666667e-1);
    const double sr = fma(r * r2, sp, r);
    double cp = 4.7794773323873852974e-14; cp = fma(cp, r2, -1.1470745597729724714e-11); cp = fma(cp, r2, 2.0876756987868098979e-9); cp = fma(cp, r2, -2.7557319223985890653e-7);
    cp = fma(cp, r2, 2.4801587301587301587e-5); cp = fma(cp, r2, -1.3888888888888888889e-3); cp = fma(cp, r2, 4.1666666666666666667e-2); cp = fma(cp, r2, -0.5);
    const double cr = fma(r2, cp, 1.0);
    const int qi = ((int)q) & 3;
    const double sv = (qi == 0) ? sr : (qi == 1) ? cr : (qi == 2) ? -sr : -cr;
    const double cv = (qi == 0) ? cr : (qi == 1) ? -sr : (qi == 2) ? -cr : sr;
    c = (float)cv; s = (float)sv;
}

__device__ __forceinline__ void phase0(const Args& a, LAS unsigned char* lds) {
    const int tid = threadIdx.x, G = gridDim.x, wid = tid >> 6, lane = tid & 63;
    const int gw = blockIdx.x * 8 + wid, NW = G * 8;
    unsigned char* ws = a.ws;
    { float* rope = (float*)(ws + WS_ROPE);
      for (int e = blockIdx.x * 512 + tid; e < 288 * 8; e += G * 512) {
          const int q = e >> 3, i = e & 7; const float iv = (i == 0) ? a.inv0 : (i == 1) ? a.inv1 : (i == 2) ? a.inv2 : (i == 3) ? a.inv3 : (i == 4) ? a.inv4 : (i == 5) ? a.inv5 : (i == 6) ? a.inv6 : a.inv7;
          const int pos = (q < 256) ? q : (q - 256) * 256; float c, s; sincos_d((double)pos * (double)iv, c, s);
          rope[q * 16 + i] = c; rope[q * 16 + 8 + i] = s; } }
    { bf16_t* WT = (bf16_t*)(ws + WS_WT);
      LAS unsigned char* tile = lds + wid * 8448;
      for (int t = gw; t < (WROWS / 64) * 16; t += NW) {
          const int n0 = (t >> 4) * 64, k0 = (t & 15) * 64;
          const int np = n0 + lane;
          const float* W; int ld, col; const float* gain = nullptr;
          if (np < WROW2) { const int pn = np >> 8, ct = np & 255, bj = ct >> 7, wc = (ct >> 5) & 3, n = (ct >> 4) & 1, cc = ct & 15; W = a.w_in_a; ld = 4096; col = (2 * bj + n) * 1024 + 64 * pn + 16 * wc + (8 * ((cc >> 2) & 1) + 4 * (cc >> 3) + (cc & 3)); }
          else if (np < WROW3) { W = a.w_out_a; ld = 1024; col = np - WROW2; }
          else if (np < WROW4) { const int n3 = np - WROW3, pn = n3 >> 8, ct = n3 & 255, bj = ct >> 7, wc = (ct >> 5) & 3, cc = ct & 31; const int oc = 256 * pn + 64 * wc + 32 * bj + cc;
              if (oc < 512) { W = a.w_kv; ld = 512; col = oc; gain = a.ln_kv; } else { W = a.w_in_b; ld = 2048; col = oc - 512; gain = a.ln_b; } }
          else { W = a.w_out_b; ld = 1024; col = np - WROW4; }
          const float* src = W + (size_t)k0 * ld + col;
#pragma unroll
          for (int kb = 0; kb < 64; kb += 16) {
              float v[16];
#pragma unroll
              for (int i = 0; i < 16; ++i) v[i] = __builtin_nontemporal_load(src + (size_t)(kb + i) * ld);
              if (gain) {
#pragma unroll
                  for (int i = 0; i < 16; ++i) v[i] *= gain[k0 + kb + i];
              }
#pragma unroll
              for (int i = 0; i < 8; ++i) *(LAS unsigned*)(tile + lane * 132 + (kb + 2 * i) * 2) = cvt_pk_bf16(v[2 * i], v[2 * i + 1]);
          }
          asm volatile("s_waitcnt lgkmcnt(0)" ::: "memory");
#pragma unroll
          for (int it = 0; it < 8; ++it) {
              const int nl = it * 8 + (lane >> 3), k8 = (lane & 7) * 8;
              const LAS unsigned* rp = (const LAS unsigned*)(tile + nl * 132 + k8 * 2);
              u32x4 o; o.x = rp[0]; o.y = rp[1]; o.z = rp[2]; o.w = rp[3];
              *(u32x4*)(WT + (size_t)(n0 + nl) * D_ + k0 + k8) = o;
          }
          asm volatile("s_waitcnt lgkmcnt(0)" ::: "memory");
      } }
    { bf16_t* HB = (bf16_t*)(ws + WS_R0);
      f32x4 gv[4];
#pragma unroll
      for (int i = 0; i < 4; ++i) gv[i] = *(const f32x4*)(a.ln_a + i * 256 + lane * 4);
      for (int row = gw * 2; row < M_; row += NW * 2) {
          f32x4 xv[2][4];
#pragma unroll
          for (int rr = 0; rr < 2; ++rr)
#pragma unroll
              for (int i = 0; i < 4; ++i) xv[rr][i] = __builtin_nontemporal_load((const f32x4*)(a.x + (size_t)(row + rr) * D_ + i * 256 + lane * 4));
#pragma unroll
          for (int rr = 0; rr < 2; ++rr) {
              float ss = 0.f;
#pragma unroll
              for (int i = 0; i < 4; ++i) ss += (xv[rr][i][0] * xv[rr][i][0] + xv[rr][i][1] * xv[rr][i][1]) + (xv[rr][i][2] * xv[rr][i][2] + xv[rr][i][3] * xv[rr][i][3]);
#pragma unroll
              for (int o = 32; o >= 1; o >>= 1) ss += __shfl_xor(ss, o);
              const float ms = ss * (1.0f / 1024.0f) + EPS_;
              const float rstd = rsqrtf(ms);
              if (lane == 0) ((float*)(ws + WS_RSTD0))[row + rr] = sqrtf(ms);
#pragma unroll
              for (int i = 0; i < 4; ++i) st_bf16x4(HB + (size_t)(row + rr) * D_ + i * 256 + lane * 4, xv[rr][i] * rstd * gv[i]);
          }
      } }
    __syncthreads();
}

__device__ __forceinline__ void patch_y(const Args& a, int pm) {
    if ((pm & 31) == 0) return;
    unsigned char* ws = a.ws; const int tid = threadIdx.x, r = tid >> 8, c4 = (tid & 255) * 4;
    const float* VL = (const float*)(ws + WS_VL); const float* Gp = (const float*)(ws + WS_G); const float* YP = (const float*)(ws + WS_YP);
    const f32x4 yp = *(const f32x4*)(YP + (size_t)(pm * 2 + r) * D_ + c4), gt = *(const f32x4*)(Gp + (size_t)(pm * 2 + r) * D_ + c4);
    const f32x4 vl0 = *(const f32x4*)(VL + (size_t)((pm - 1) * 2 + 0) * D_ + c4), vl1 = *(const f32x4*)(VL + (size_t)((pm - 1) * 2 + 1) * D_ + c4);
    const f32x4 w0 = *(const f32x4*)(a.conv_a + c4), w1 = *(const f32x4*)(a.conv_a + 1024 + c4);
    const f32x4 add = (r == 0) ? (w0 * vl0 + w1 * vl1) : (w0 * vl1);
    st_bf16x4((bf16_t*)(ws + WS_R1) + (size_t)(pm * BM + r) * D_ + c4, yp + gt * add);
}

constexpr int KS_STRIDE = 144, VT_OFF = 256 * KS_STRIDE, VT_STRIDE = 528, ATT_BUF = VT_OFF + 64 * VT_STRIDE;
static_assert(2 * ATT_BUF <= XBST_OFF, "attention double buffer must stay below the barrier's LDS words");
__device__ __forceinline__ void attn_load_k(const bf16_t* KB, int it, int tid, u32x4 (&kr)[4]) {
    const int kvh = it & 3, blk = (it >> 2) & 63, b = it >> 8, t0 = b * SEQ_ + blk * 128;
    const bf16_t* p = KB + (size_t)(t0 - 128) * 256 + kvh * 64 + (tid >> 3) * 256 + (tid & 7) * 8;
#pragma unroll
    for (int i = 0; i < 4; ++i) { kr[i] = (u32x4){0u, 0u, 0u, 0u}; if (blk > 0 || i >= 2) kr[i] = *(const u32x4*)(p + i * 64 * 256); }
}
__device__ __forceinline__ void attn_load_v(const bf16_t* VB, int it, int tid, u32x4 (&vr)[4]) {
    const int kvh = it & 3, blk = (it >> 2) & 63, b = it >> 8, t0 = b * SEQ_ + blk * 128;
    const bf16_t* p = VB + (size_t)(t0 - 128) * 256 + kvh * 64 + (tid >> 3) * 512 + (tid & 7) * 8;
#pragma unroll
    for (int i = 0; i < 2; ++i)
#pragma unroll
        for (int kk = 0; kk < 2; ++kk) { vr[i * 2 + kk] = (u32x4){0u, 0u, 0u, 0u}; if (blk > 0 || i >= 1) vr[i * 2 + kk] = *(const u32x4*)(p + i * 128 * 256 + kk * 256); }
}
__device__ __forceinline__ void attn_store_k(LAS unsigned char* buf, int tid, const u32x4 (&kr)[4]) {
    LAS unsigned char* p = buf + (tid >> 3) * KS_STRIDE + (tid & 7) * 16;
#pragma unroll
    for (int i = 0; i < 4; ++i) *(LAS u32x4*)(p + i * 64 * KS_STRIDE) = kr[i];
}
__device__ __forceinline__ void attn_store_v(LAS unsigned char* buf, int tid, const u32x4 (&vr)[4]) {
    const int key0 = 2 * (tid >> 3), k16 = key0 & 15;
    const int pos = (key0 & ~15) | (8 * ((k16 >> 2) & 1) + 4 * (k16 >> 3) + (k16 & 3));
    LAS unsigned char* p = buf + VT_OFF + ((tid & 7) * 8) * VT_STRIDE + pos * 2;
#pragma unroll
    for (int i = 0; i < 2; ++i) {
        const u32x4 va = vr[i * 2], vb = vr[i * 2 + 1];
#pragma unroll
        for (int e2 = 0; e2 < 4; ++e2) {
            *(LAS unsigned*)(p + i * 256 + (2 * e2) * VT_STRIDE) = (va[e2] & 0xffffu) | (vb[e2] << 16);
            *(LAS unsigned*)(p + i * 256 + (2 * e2 + 1) * VT_STRIDE) = (va[e2] >> 16) | (vb[e2] & 0xffff0000u);
        }
    }
}
__device__ __forceinline__ void attn_load_q(const bf16_t* QB, int it, int wid, int sb, int r, int h, bf16x8 (&qf)[4]) {
    const int kvh = it & 3, blk = (it >> 2) & 63, b = it >> 8, t0 = b * SEQ_ + blk * 128, a0 = (wid & 1) * 64 + sb * 32, hq = kvh * 4 + (wid >> 1);
    const bf16_t* qp = QB + (size_t)(t0 + a0 + r) * D_ + hq * 64 + 8 * h;
#pragma unroll
    for (int kk = 0; kk < 4; ++kk) qf[kk] = *(const bf16x8*)(qp + 16 * kk);
}
__device__ __forceinline__ void attn_sub(const LAS unsigned char* buf, const bf16x8 (&qf)[4], const bf16_t* ZB, bf16_t* OG, int t0, int a0, int blk, int hq, float sink2, float mshift, int r, int h) {
    const int kt0 = a0 >> 5;
    const size_t rowoff = (size_t)(t0 + a0 + r) * D_ + hq * 64;
    f32x16 S[5];
#pragma unroll
    for (int t = 0; t < 5; ++t) {
#pragma unroll
        for (int i = 0; i < 16; ++i) S[t][i] = 0.f;
#pragma unroll
        for (int kk = 0; kk < 4; ++kk) { const bf16x8 kf = *(const LAS bf16x8*)(buf + (32 * (kt0 + t) + r) * KS_STRIDE + (16 * kk + 8 * h) * 2); S[t] = __builtin_amdgcn_mfma_f32_32x32x16_bf16(kf, qf[kk], S[t], 0, 0, 0); }
    }
    u32x4 zq[2][2];
#pragma unroll
    for (int db = 0; db < 2; ++db)
#pragma unroll
        for (int pr = 0; pr < 2; ++pr) zq[db][pr] = *(const u32x4*)(ZB + rowoff + 32 * db + 16 * pr + 8 * h);
    const int rr = r - 4 * h;
#pragma unroll
    for (int i = 0; i < 16; ++i) { const int ci = (i & 3) + 8 * (i >> 2); S[0][i] = (ci > rr) ? S[0][i] : -1e30f; S[4][i] = (ci <= rr) ? S[4][i] : -1e30f; }
    if (blk == 0) {
#pragma unroll
        for (int t = 0; t < 4; ++t) if (kt0 + t < 4) {
#pragma unroll
            for (int i = 0; i < 16; ++i) S[t][i] = -1e30f; }
    }
    if (mshift != 0.f) {
#pragma unroll
        for (int t = 0; t < 5; ++t)
#pragma unroll
            for (int i = 0; i < 16; ++i) S[t][i] -= mshift;
    }
    float sum = 0.f;
#pragma unroll
    for (int t = 0; t < 5; ++t)
#pragma unroll
        for (int i = 0; i < 16; ++i) { const float p = __builtin_amdgcn_exp2f(S[t][i]); S[t][i] = p; sum += p; }
    { auto rr = __builtin_amdgcn_permlane32_swap(__float_as_uint(sum), __float_as_uint(sum), false, false); sum = __uint_as_float(rr[0]) + __uint_as_float(rr[1]); }
    sum += __builtin_amdgcn_exp2f(sink2 - mshift);
    const float inv = __builtin_amdgcn_rcpf(sum);
    f32x16 O[2];
#pragma unroll
    for (int db = 0; db < 2; ++db)
#pragma unroll
        for (int i = 0; i < 16; ++i) O[db][i] = 0.f;
#pragma unroll
    for (int t = 0; t < 5; ++t)
#pragma unroll
        for (int s = 0; s < 2; ++s) {
            u32x4 pk; pk.x = cvt_pk_bf16(S[t][8 * s + 0], S[t][8 * s + 1]); pk.y = cvt_pk_bf16(S[t][8 * s + 2], S[t][8 * s + 3]); pk.z = cvt_pk_bf16(S[t][8 * s + 4], S[t][8 * s + 5]); pk.w = cvt_pk_bf16(S[t][8 * s + 6], S[t][8 * s + 7]);
            const bf16x8 pf = __builtin_bit_cast(bf16x8, pk);
#pragma unroll
            for (int db = 0; db < 2; ++db) { const bf16x8 vf = *(const LAS bf16x8*)(buf + VT_OFF + (32 * db + r) * VT_STRIDE + (32 * (kt0 + t) + 16 * s + 8 * h) * 2); O[db] = __builtin_amdgcn_mfma_f32_32x32x16_bf16(vf, pf, O[db], 0, 0, 0); }
        }
#pragma unroll
    for (int db = 0; db < 2; ++db)
#pragma unroll
        for (int pr = 0; pr < 2; ++pr) {
            u32x4 z4 = zq[db][pr];
            { auto r0 = __builtin_amdgcn_permlane32_swap(z4.x, z4.z, false, false); auto r1 = __builtin_amdgcn_permlane32_swap(z4.y, z4.w, false, false); z4.x = r0[0]; z4.z = r0[1]; z4.y = r1[0]; z4.w = r1[1]; }
            const int ia = 8 * pr, ib = 8 * pr + 4;
            unsigned a0 = cvt_pk_bf16(O[db][ia + 0] * inv * __uint_as_float(z4.x << 16), O[db][ia + 1] * inv * __uint_as_float(z4.x & 0xffff0000u));
            unsigned a1 = cvt_pk_bf16(O[db][ia + 2] * inv * __uint_as_float(z4.y << 16), O[db][ia + 3] * inv * __uint_as_float(z4.y & 0xffff0000u));
            unsigned b0 = cvt_pk_bf16(O[db][ib + 0] * inv * __uint_as_float(z4.z << 16), O[db][ib + 1] * inv * __uint_as_float(z4.z & 0xffff0000u));
            unsigned b1 = cvt_pk_bf16(O[db][ib + 2] * inv * __uint_as_float(z4.w << 16), O[db][ib + 3] * inv * __uint_as_float(z4.w & 0xffff0000u));
            { auto r0 = __builtin_amdgcn_permlane32_swap(a0, b0, false, false); auto r1 = __builtin_amdgcn_permlane32_swap(a1, b1, false, false); a0 = r0[0]; b0 = r0[1]; a1 = r1[0]; b1 = r1[1]; }
            *(u32x4*)(OG + rowoff + 32 * db + 16 * pr + 8 * h) = (u32x4){a0, a1, b0, b1};
        }
}
__device__ __forceinline__ void attn_phase(const Args& a, LAS unsigned char* lds) {
    const int tid = threadIdx.x, wid = tid >> 6, lane = tid & 63, r = lane & 31, h = lane >> 5, G = gridDim.x;
    unsigned char* ws = a.ws;
    const bf16_t* KB = (const bf16_t*)(ws + WS_KB); const bf16_t* VB = (const bf16_t*)(ws + WS_VB); const bf16_t* QB = (const bf16_t*)(ws + WS_R1);
    const bf16_t* ZB = (const bf16_t*)(ws + WS_ZB); bf16_t* OG = (bf16_t*)(ws + WS_OG);
    float m0;
    { float gq = fabsf(a.q_norm[lane]), gk = fabsf(a.k_norm[lane]);
#pragma unroll
      for (int o = 32; o >= 1; o >>= 1) { gq = fmaxf(gq, __shfl_xor(gq, o)); gk = fmaxf(gk, __shfl_xor(gk, o)); }
      m0 = 11.6f * gq * gk; }
    u32x4 kr[4], vr[4];
    bf16x8 qa[4], qb[4];
    int it = blockIdx.x;
    if (it < 1024) { attn_load_k(KB, it, tid, kr); attn_load_v(VB, it, tid, vr); attn_load_q(QB, it, wid, 0, r, h, qa); attn_store_k(lds, tid, kr); attn_store_v(lds, tid, vr); }
    __syncthreads();
    for (int n = 0; it < 1024; it += G, ++n) {
        const LAS unsigned char* buf = lds + (n & 1) * ATT_BUF; LAS unsigned char* nbuf = lds + ((n + 1) & 1) * ATT_BUF;
        const int kvh = it & 3, blk = (it >> 2) & 63, b = it >> 8, t0 = b * SEQ_ + blk * 128;
        const bool hasn = (it + G) < 1024;
        if (hasn) attn_load_k(KB, it + G, tid, kr);
        attn_load_q(QB, it, wid, 1, r, h, qb);
        const int g = wid >> 1, hq = kvh * 4 + g; const float sink2 = a.sinks[hq] * 1.4426950408889634f; const float mb = fmaxf(m0, sink2), mshift = (mb > 60.f) ? mb : 0.f;
        attn_sub(buf, qa, ZB, OG, t0, (wid & 1) * 64, blk, hq, sink2, mshift, r, h);
        if (hasn) { attn_store_k(nbuf, tid, kr); attn_load_v(VB, it + G, tid, vr); attn_load_q(QB, it + G, wid, 0, r, h, qa); }
        attn_sub(buf, qb, ZB, OG, t0, (wid & 1) * 64 + 32, blk, hq, sink2, mshift, r, h);
        if (hasn) attn_store_v(nbuf, tid, vr);
        __syncthreads();
    }
}

#define XB_TMO      128
#define XB_XCNT(j)  (256  + 64 * (j))
#define XB_XSUB(j)  (1280 + 64 * (j))
#define XB_XGEN(j)  (2304 + 64 * (j))
#define XB_TOP      3328
#define XB_TOPGEN   3392
#define XCD_BAR_WORDS 3456
#define XB_SPIN_CAP (1u << 18)
__device__ __forceinline__ unsigned xb_ld(unsigned* p)              { return __hip_atomic_load(p, __ATOMIC_RELAXED, __HIP_MEMORY_SCOPE_AGENT); }
__device__ __forceinline__ unsigned xb_add(unsigned* p, unsigned v) { return __hip_atomic_fetch_add(p, v, __ATOMIC_RELAXED, __HIP_MEMORY_SCOPE_AGENT); }
__device__ __forceinline__ unsigned xb_xcc_id() { return (unsigned)__builtin_amdgcn_s_getreg((3 << 11) | 20) & 0xFu; }
#define XB_SPIN(cond, bar) do { unsigned _sp = 0; while (cond) { __builtin_amdgcn_s_sleep(1); \
    if ((++_sp & 255u) == 0u) { if (xb_ld(&(bar)[XB_TMO])) break; if (_sp > XB_SPIN_CAP) { atomicAdd(&(bar)[XB_TMO], 1u); break; } } } } while (0)
struct XcdBarrier { unsigned* bar; unsigned x; volatile LAS unsigned* st; };
__device__ __forceinline__ XcdBarrier xcd_barrier_post(unsigned* bar, volatile LAS unsigned* st) {
    XcdBarrier b; b.bar = bar; b.x = xb_xcc_id(); b.st = st;
    if (threadIdx.x == 0) (void)xb_add(&bar[XB_XCNT(b.x)], 1u);
    return b;
}
__device__ __forceinline__ void xcd_barrier_complete(unsigned* bar, unsigned x, unsigned& nloc, unsigned& nx) {
    const unsigned G = gridDim.x * gridDim.y * gridDim.z;
    unsigned sum, cnt, mine, sp = 0u;
    for (;;) {
        sum = 0u; cnt = 0u; mine = 0u;
#pragma unroll
        for (unsigned j = 0; j < 16; ++j) { const unsigned c = xb_ld(&bar[XB_XCNT(j)]); sum += c; cnt += (c > 0u) ? 1u : 0u; mine = (j == x) ? c : mine; }
        if (sum == G) break;
        __builtin_amdgcn_s_sleep(1);
        if ((++sp & 255u) == 0u) { if (xb_ld(&bar[XB_TMO])) break; if (sp > XB_SPIN_CAP) { atomicAdd(&bar[XB_TMO], 1u); break; } }
    }
    nloc = mine > 0u ? mine : 1u; nx = cnt > 0u ? cnt : 1u;
}
__device__ __forceinline__ void xcd_barrier(const XcdBarrier& b) {
    asm volatile("s_waitcnt vmcnt(0)" ::: "memory");
    __syncthreads();
    if (threadIdx.x == 0) {
        unsigned* bar = b.bar;
        __builtin_amdgcn_s_waitcnt(0);
        unsigned nloc = b.st[0], nx = b.st[1];
        if (nloc == 0u) { xcd_barrier_complete(bar, b.x, nloc, nx); b.st[0] = nloc; b.st[1] = nx; }
        const unsigned old = xb_add(&bar[XB_XSUB(b.x)], 1u);
        const unsigned gen = old / nloc;
        if (old + 1u == (gen + 1u) * nloc) {
            __builtin_amdgcn_fence(__ATOMIC_RELEASE, "agent");
            asm volatile("s_waitcnt vmcnt(0)" ::: "memory");
            const unsigned og = xb_add(&bar[XB_TOP], 1u);
            const unsigned tg = og / nx;
            if (og + 1u == (tg + 1u) * nx) xb_add(&bar[XB_TOPGEN], 1u);
            else XB_SPIN(xb_ld(&bar[XB_TOPGEN]) == tg, bar);
            __builtin_amdgcn_fence(__ATOMIC_ACQUIRE, "agent");
            xb_add(&bar[XB_XGEN(b.x)], 1u);
            asm volatile("s_waitcnt vmcnt(0)" ::: "memory");
        } else {
            XB_SPIN(xb_ld(&bar[XB_XGEN(b.x)]) == gen, bar);
            __builtin_amdgcn_fence(__ATOMIC_ACQUIRE, "agent");
            asm volatile("s_waitcnt vmcnt(0)" ::: "memory");
        }
    }
    __syncthreads();
}

__global__ void __launch_bounds__(512, 2) fwd(Args a) {
    extern __shared__ __attribute__((aligned(16))) unsigned char lds_raw[];
    LAS unsigned char* lds = (LAS unsigned char*)lds_raw;
    unsigned char* ws = a.ws;
    const int G = gridDim.x;
    bf16_t* WT = (bf16_t*)(ws + WS_WT);
#if MEGA
    cg::grid_group grid = cg::this_grid();
    unsigned* barw = (unsigned*)(ws + WS_BAR);
    volatile LAS unsigned* xst = (volatile LAS unsigned*)(lds + XBST_OFF);
    if (threadIdx.x < 4) xst[threadIdx.x] = 0u;
    __syncthreads();
    XcdBarrier xb = xcd_barrier_post(barw, xst);
    if (a.lo < 0) grid.sync();
#define SEAM0() xcd_barrier(xb)
#define SEAM() xcd_barrier(xb)
#else
#define SEAM0() do {} while (0)
#define SEAM() do {} while (0)
#endif
#define IN(k) (a.lo <= (k) && (k) < a.hi)
    if (IN(0)) phase0(a, lds);
    if (IN(0) && IN(1)) SEAM0();
    if (IN(1)) {
        Gemm g{(const bf16_t*)(ws + WS_R0), WT + (size_t)WROW1 * D_, M_, 4096, D_}; StaticOrder S; S.init(M_, 4096, G, (int)blockIdx.x);
        Epi1 E{(bf16_t*)(ws + WS_R1), a.conv_a, (float*)(ws + WS_VL), (float*)(ws + WS_G), (float*)(ws + WS_YP), (LAS float*)(lds + HALO_OFF)};
        gemm_phase<Epi1>(lds, g, S, E);
    }
    if (IN(1) && IN(2)) SEAM();
    if (IN(2)) {
        StaticOrder S; S.init(M_, 1024, G, (int)blockIdx.x);
        { Unit u; for (int i = 0; S.next(i, u); ++i) patch_y(a, u.pm); }
        { LAS float* it = (LAS float*)(lds + RSTD_OFF); const float* rs0 = (const float*)(ws + WS_RSTD0);
          Unit u; for (int i = 0; i < 8 && S.next(i, u); ++i) if (threadIdx.x < 256) it[i * 256 + threadIdx.x] = rs0[u.pm * BM + threadIdx.x];
          LAS float* ig = (LAS float*)(lds + ROPER_OFF);
          for (int i = threadIdx.x; i < D_; i += 512) ig[i] = 1.0f / a.ln_a[i]; }
        __threadfence(); __syncthreads();
        Gemm g{(const bf16_t*)(ws + WS_R1), WT + (size_t)WROW2 * D_, M_, 1024, D_};
        Epi2 E{(bf16_t*)(ws + WS_R0), (float*)(ws + WS_SSQ), (const LAS float*)(lds + RSTD_OFF), (const LAS float*)(lds + ROPER_OFF)};
        gemm_phase<Epi2>(lds, g, S, E);
    }
    if (IN(2) && IN(3)) SEAM();
    if (IN(3)) {
        Gemm g{(const bf16_t*)(ws + WS_R0), WT + (size_t)WROW3 * D_, M_, 2560, D_}; StaticOrder S; S.init(M_, 2560, G, (int)blockIdx.x);
        { LAS float* rt = (LAS float*)(lds + RSTD_OFF); const float* SSQ = (const float*)(ws + WS_SSQ);
          Unit u; for (int i = 0; i < 8 && S.next(i, u); ++i)
              if (threadIdx.x < 256) { const f32x4* sp = (const f32x4*)(SSQ + (size_t)(u.pm * BM + threadIdx.x) * 16); const f32x4 s0 = sp[0], s1 = sp[1], s2 = sp[2], s3 = sp[3];
                  const float tot = ((s0[0] + s0[1]) + (s0[2] + s0[3])) + ((s1[0] + s1[1]) + (s1[2] + s1[3])) + ((s2[0] + s2[1]) + (s2[2] + s2[3])) + ((s3[0] + s3[1]) + (s3[2] + s3[3]));
                  rt[i * 256 + threadIdx.x] = rsqrtf(tot * (1.0f / 1024.0f) + EPS_); }
          const float* ropeG = (const float*)(ws + WS_ROPE);
          for (int i = threadIdx.x; i < 1024; i += 512) *(LAS f32x4*)(lds + ROPER_OFF + i * 16) = *(const f32x4*)(ropeG + i * 4);
          if (threadIdx.x < 128) ((LAS float*)(lds + GAIN_OFF))[threadIdx.x] = (threadIdx.x < 64) ? a.k_norm[threadIdx.x] : a.q_norm[threadIdx.x - 64];
          __syncthreads(); }
        Epi3 E{(const LAS float*)(lds + RSTD_OFF), (const LAS float*)(lds + ROPER_OFF), (const LAS float*)(lds + GAIN_OFF), (const float*)(ws + WS_ROPE) + 256 * 16, (bf16_t*)(ws + WS_KB), (bf16_t*)(ws + WS_VB), (bf16_t*)(ws + WS_R1), (bf16_t*)(ws + WS_ZB)};
        gemm_phase<Epi3>(lds, g, S, E);
    }
    if (IN(3) && IN(4)) SEAM();
    if (IN(4)) attn_phase(a, lds);
    if (IN(4) && IN(5)) SEAM();
    if (IN(5)) {
        Gemm g{(const bf16_t*)(ws + WS_OG), WT + (size_t)WROW4 * D_, M_, 1024, D_}; StaticOrder S; S.init(M_, 1024, G, (int)blockIdx.x);
        Epi4 E{(const bf16_t*)(ws + WS_R0), a.out};
        gemm_phase<Epi4>(lds, g, S, E);
    }
}

extern "C" void kernel_launch(void* const* d_in, const int* in_sizes, int n_in, void* d_out, int out_size, void* d_ws, size_t ws_size, hipStream_t stream) {
    static int grid = 0;
    if (grid == 0) {
        if (n_in != 13 || out_size != M_ * D_ || ws_size < WS_END) { fprintf(stderr, "kernel_launch: unexpected shapes (n_in %d out %d ws %zu)\n", n_in, out_size, ws_size); grid = -1; return; }
        int dev = 0, cus = 0, per_cu = 0;
        (void)hipGetDevice(&dev); (void)hipDeviceGetAttribute(&cus, hipDeviceAttributeMultiprocessorCount, dev);
        if (hipFuncSetAttribute((const void*)fwd, hipFuncAttributeMaxDynamicSharedMemorySize, LDS_BYTES) != hipSuccess) { fprintf(stderr, "kernel_launch: hipFuncSetAttribute failed\n"); grid = -1; return; }
        if (hipOccupancyMaxActiveBlocksPerMultiprocessor(&per_cu, (const void*)fwd, 512, LDS_BYTES) != hipSuccess || per_cu < 1) { fprintf(stderr, "kernel_launch: occupancy query failed (%d)\n", per_cu); (void)hipGetLastError(); per_cu = 1; }
        grid = cus * 1;
        (void)per_cu;
    }
    if (grid < 0) return;
    Args a{};
    a.x = (const float*)d_in[0]; a.ln_a = (const float*)d_in[1]; a.w_in_a = (const float*)d_in[2]; a.conv_a = (const float*)d_in[3]; a.w_out_a = (const float*)d_in[4];
    a.ln_kv = (const float*)d_in[5]; a.w_kv = (const float*)d_in[6]; a.k_norm = (const float*)d_in[7]; a.ln_b = (const float*)d_in[8]; a.w_in_b = (const float*)d_in[9];
    a.q_norm = (const float*)d_in[10]; a.sinks = (const float*)d_in[11]; a.w_out_b = (const float*)d_in[12];
    a.out = (float*)d_out; a.ws = (unsigned char*)d_ws + ((ws_size - WS_END) & ~(size_t)0xFFFFF);
    { float iv[8]; for (int i = 0; i < 8; ++i) iv[i] = (float)std::pow(500000.0, -(double)i / 8.0);
      a.inv0 = iv[0]; a.inv1 = iv[1]; a.inv2 = iv[2]; a.inv3 = iv[3]; a.inv4 = iv[4]; a.inv5 = iv[5]; a.inv6 = iv[6]; a.inv7 = iv[7]; }
#if MEGA
    a.lo = 0; a.hi = 6;
    if (hipMemsetAsync((char*)a.ws + WS_BAR, 0, XCD_BAR_WORDS * 4, stream) != hipSuccess) { fprintf(stderr, "kernel_launch: memset of barrier words failed\n"); return; }
    void* args[] = {&a};
    hipError_t e = hipLaunchCooperativeKernel((const void*)fwd, dim3(grid), dim3(512), args, LDS_BYTES, stream);
    if (e != hipSuccess) fprintf(stderr, "cooperative launch failed: %s (grid %d)\n", hipGetErrorString(e), grid);
#else
    for (int p = 0; p < 6; ++p) { a.lo = p; a.hi = p + 1; hipLaunchKernelGGL(fwd, dim3(grid), dim3(512), LDS_BYTES, stream, a); }
#endif
}
```

```cpp
#include <hip/hip_runtime.h>
#include <hip/hip_cooperative_groups.h>
#include <cstdio>
#include <cmath>
namespace cg = cooperative_groups;

#ifndef MEGA
#define MEGA 1
#endif

#define LAS __attribute__((address_space(3)))
typedef unsigned short bf16_t;
typedef short bf16x8 __attribute__((ext_vector_type(8)));
typedef float f32x4 __attribute__((ext_vector_type(4)));
typedef float f32x16 __attribute__((ext_vector_type(16)));
typedef unsigned u32x4 __attribute__((ext_vector_type(4)));
typedef unsigned u32x2 __attribute__((ext_vector_type(2)));

constexpr int M_ = 32768, D_ = 1024, SEQ_ = 8192;
constexpr float EPS_ = 1e-6f;
constexpr int BM = 256, BK = 64, HALF = 128, HTB = HALF * BK * 2, STAGE_BYTES = 8 * HTB, NXCD = 8, WGM = 8;
constexpr int HALO_OFF = STAGE_BYTES;
constexpr int RSTD_OFF = STAGE_BYTES + 2048;
constexpr int XBST_OFF = STAGE_BYTES + 2048 + 8192;
constexpr int ROPER_OFF = XBST_OFF + 64;
constexpr int GAIN_OFF = ROPER_OFF + 16384;
constexpr int LDS_BYTES = GAIN_OFF + 512;

constexpr size_t MB = 1024 * 1024;
constexpr size_t WS_R0 = 256 * MB;
constexpr size_t WS_R1 = 64 * MB;
constexpr size_t WS_ZB = 128 * MB;
constexpr size_t WS_KB = 192 * MB;
constexpr size_t WS_VB = 208 * MB;
constexpr size_t WS_WT = 224 * MB;
constexpr size_t WS_SSQ = 242 * MB;
constexpr size_t WS_ROPE = 245 * MB;
constexpr size_t WS_VL = 246 * MB;
constexpr size_t WS_G = 247 * MB;
constexpr size_t WS_YP = 248 * MB;
constexpr size_t WS_OG = WS_R1;
constexpr size_t WS_BAR = 320 * MB;
constexpr size_t WS_RSTD0 = 321 * MB;
constexpr size_t WS_END = 322 * MB;
constexpr int WROW1 = 0, WROW2 = 4096, WROW3 = 5120, WROW4 = 7680, WROWS = 8704;

struct Args {
    const float* x; const float* ln_a; const float* w_in_a; const float* conv_a; const float* w_out_a;
    const float* ln_kv; const float* w_kv; const float* k_norm; const float* ln_b; const float* w_in_b;
    const float* q_norm; const float* sinks; const float* w_out_b;
    float* out; unsigned char* ws;
    float inv0, inv1, inv2, inv3, inv4, inv5, inv6, inv7;
    int lo, hi;
};

typedef float f32x2_t __attribute__((ext_vector_type(2)));
typedef __bf16 bf16x2_t __attribute__((ext_vector_type(2)));
__device__ __forceinline__ unsigned cvt_pk_bf16(float lo, float hi) { const f32x2_t v = {lo, hi}; return __builtin_bit_cast(unsigned, __builtin_convertvector(v, bf16x2_t)); }
__device__ __forceinline__ bf16_t f2bf(float f) { unsigned u = __float_as_uint(f); u += 0x7FFFu + ((u >> 16) & 1u); return (bf16_t)(u >> 16); }
__device__ __forceinline__ float bf2f(unsigned short b) { return __uint_as_float(((unsigned)b) << 16); }
__device__ __forceinline__ float silu_f(float z) { return z * __builtin_amdgcn_rcpf(1.0f + __expf(-z)); }

__host__ __device__ __forceinline__ int lds_byte(int r, int c) { const int st = (r >> 4) * 2 + (c >> 5), rr = r & 15, cc = c & 31, ob = rr * 64 + cc * 2; return st * 1024 + (ob ^ (((ob >> 9) & 1) << 5)); }
__host__ __device__ __forceinline__ void stage_rc(int b, int& R, int& C) { const int st = b / 1024, sb = b % 1024, swz = sb ^ (((sb >> 9) & 1) << 5); R = (st >> 1) * 16 + swz / 64; C = (st & 1) * 32 + (swz % 64) / 2; }

__host__ __device__ __forceinline__ int perm32(int rho) { const int n = rho >> 4, i = rho & 15; return 8 * (i >> 2) + 4 * n + (i & 3); }
struct Unit { int pm, pn; };
struct Gemm { const bf16_t* A; const bf16_t* Bt; int M, N, K; };
struct StaticOrder {
    int nM, nN, nwg, G, c;
    __device__ void init(int M, int N, int G_, int c_) { nM = M / BM; nN = N / BM; nwg = nM * nN; G = G_; c = c_; }
    __device__ bool next(int i, Unit& u) const {
        const long L = (long)i * G + c; if (L >= nwg) return false;
        int wgid = (int)L; { const int q = nwg / NXCD, r = nwg % NXCD, xcd = wgid % NXCD, off = wgid / NXCD; wgid = (xcd < r ? xcd * (q + 1) : r * (q + 1) + (xcd - r) * q) + off; }
        const int nig = WGM * nN, gid = wgid / nig, fm = gid * WGM, gsz = (nM - fm) < WGM ? (nM - fm) : WGM;
        u.pm = fm + ((wgid % nig) % gsz); u.pn = (wgid % nig) / gsz; return true;
    }
};

template <class Epi>
__device__ __forceinline__ void gemm_phase(LAS unsigned char* lds, const Gemm g, const StaticOrder& S, const Epi& E) {
    const int tid = threadIdx.x, wid = __builtin_amdgcn_readfirstlane(tid >> 6), lane = tid & 63, wr = wid >> 2, wc = wid & 3, fr = lane & 15, fq = lane >> 4;
    const int K = g.K, nt = K / BK;
    unsigned voffA[2], voffB[2];
#pragma unroll
    for (int i = 0; i < 2; ++i) { int R, C; stage_rc(tid * 16 + i * 8192, R, C); const int Rb = Epi::PERM ? ((R & ~31) + perm32(R & 31)) : R;
        const int Ra = Epi::AMAP ? (128 * (R >> 6) + (R & 63)) : R;
        voffA[i] = (unsigned)(Ra * K + C) * 2u; voffB[i] = (unsigned)(Rb * K + C) * 2u; }
    const size_t kstep = (size_t)(BK * 2);
    const size_t hstep = (size_t)HALF * K * 2;
    const size_t hstepA = Epi::AMAP ? (size_t)64 * K * 2 : hstep;
    const size_t tstep = 2 * hstep;
    const unsigned ldsw = (unsigned)wid * 1024u;
    const int aoff = lds_byte(wr * 64 + fr, fq * 8), boff = lds_byte(wc * 32 + fr, fq * 8);
#define PG8_SA(b, h) (((b) * 2 + (h)) * HTB)
#define PG8_SB(b, h) ((4 + (b) * 2 + (h)) * HTB)
#define PG8_STAGE(bufoff, gbase, voff) do { _Pragma("unroll") for (int _i = 0; _i < 2; ++_i) \
        __builtin_amdgcn_global_load_lds((const unsigned*)((const char*)(gbase) + (voff)[_i]), (LAS unsigned*)(lds + (bufoff) + ldsw + _i * 8192), 16, 0, 0); } while (0)
#define PG8_LDA(dst, b, h) do { _Pragma("unroll") for (int m = 0; m < 4; ++m) _Pragma("unroll") for (int k = 0; k < 2; ++k) dst[m][k] = *(const LAS bf16x8*)(lds + PG8_SA(b, h) + aoff + m * 2048 + k * 1024); } while (0)
#define PG8_LDB(dst, b, h) do { _Pragma("unroll") for (int n = 0; n < 2; ++n) _Pragma("unroll") for (int k = 0; k < 2; ++k) dst[n][k] = *(const LAS bf16x8*)(lds + PG8_SB(b, h) + boff + n * 2048 + k * 1024); } while (0)
#define PG8_MMA(ai, bj, At, Bt) do { __builtin_amdgcn_s_setprio(1); _Pragma("unroll") for (int m = 0; m < 4; ++m) _Pragma("unroll") for (int n = 0; n < 2; ++n) _Pragma("unroll") for (int k = 0; k < 2; ++k) \
        acc[ai][bj][m][n] = __builtin_amdgcn_mfma_f32_16x16x32_bf16(Bt[n][k], At[m][k], acc[ai][bj][m][n], 0, 0, 0); __builtin_amdgcn_s_setprio(0); } while (0)
#define PG8_WAIT_V(n) asm volatile("s_waitcnt vmcnt(" #n ")" ::: "memory")
#define PG8_WAIT_L(n) asm volatile("s_waitcnt lgkmcnt(" #n ")" ::: "memory")
#define PG8_BAR __builtin_amdgcn_s_barrier()
#define PG8_SCHED __builtin_amdgcn_sched_barrier(0)
    Unit cur, nxt; int ui = 0;
    if (!S.next(0, cur)) return;
    f32x4 acc[2][2][4][2];
#pragma unroll
    for (int a = 0; a < 2; ++a)
#pragma unroll
        for (int b = 0; b < 2; ++b)
#pragma unroll
            for (int m = 0; m < 4; ++m)
#pragma unroll
                for (int n = 0; n < 2; ++n) acc[a][b][m][n] = (f32x4){0.f, 0.f, 0.f, 0.f};
    bf16x8 At[4][2], B0[2][2], B1[2][2];
    const char* cA = (const char*)g.A + (size_t)cur.pm * tstep; const char* cB = (const char*)g.Bt + (size_t)cur.pn * tstep;
    PG8_STAGE(PG8_SB(0, 0), cB, voffB); PG8_STAGE(PG8_SB(0, 1), cB + hstep, voffB); PG8_STAGE(PG8_SA(0, 0), cA, voffA); PG8_STAGE(PG8_SA(0, 1), cA + hstepA, voffA);
    if (wr == 1) PG8_BAR;
    PG8_WAIT_V(2); PG8_BAR;
    PG8_STAGE(PG8_SB(1, 0), cB + kstep, voffB); PG8_STAGE(PG8_SA(1, 0), cA + kstep, voffA); PG8_STAGE(PG8_SB(1, 1), cB + hstep + kstep, voffB);
    PG8_WAIT_V(6); PG8_BAR;
    for (;;) {
        const bool has_next = S.next(ui + 1, nxt);
        const char* nA = has_next ? (const char*)g.A + (size_t)nxt.pm * tstep : cA; const char* nB = has_next ? (const char*)g.Bt + (size_t)nxt.pn * tstep : cB;
        for (int t = 0; t < nt; t += 2) {
            const bool last = (t == nt - 2);
            const char* a1 = cA + (size_t)(t + 1) * kstep;
            const char* a2 = last ? nA : cA + (size_t)(t + 2) * kstep; const char* b2 = last ? nB : cB + (size_t)(t + 2) * kstep;
            const char* a3 = a2 + kstep; const char* b3 = b2 + kstep;
            PG8_LDB(B0, 0, 0); PG8_LDB(B1, 0, 1); PG8_SCHED; PG8_LDA(At, 0, 0); PG8_STAGE(PG8_SA(1, 1), a1 + hstepA, voffA);
            PG8_WAIT_V(8); PG8_WAIT_L(0); PG8_BAR; PG8_MMA(0, 0, At, B0); PG8_MMA(0, 1, At, B1); PG8_BAR; PG8_SCHED;
            PG8_LDA(At, 0, 1); PG8_STAGE(PG8_SB(0, 0), b2, voffB); PG8_STAGE(PG8_SB(0, 1), b2 + hstep, voffB); PG8_STAGE(PG8_SA(0, 0), a2, voffA);
            PG8_WAIT_V(8); PG8_WAIT_L(0); PG8_BAR; PG8_MMA(1, 0, At, B0); PG8_MMA(1, 1, At, B1); PG8_BAR; PG8_SCHED;
            PG8_LDB(B0, 1, 0); PG8_LDB(B1, 1, 1); PG8_SCHED; PG8_LDA(At, 1, 0); PG8_STAGE(PG8_SA(0, 1), a2 + hstepA, voffA);
            PG8_WAIT_V(8); PG8_WAIT_L(0); PG8_BAR; PG8_MMA(0, 0, At, B0); PG8_MMA(0, 1, At, B1); PG8_BAR; PG8_SCHED;
            PG8_LDA(At, 1, 1); PG8_STAGE(PG8_SB(1, 0), b3, voffB); PG8_STAGE(PG8_SB(1, 1), b3 + hstep, voffB); PG8_STAGE(PG8_SA(1, 0), a3, voffA);
            PG8_WAIT_V(8); PG8_WAIT_L(0); PG8_BAR; PG8_MMA(1, 0, At, B0); PG8_MMA(1, 1, At, B1); PG8_BAR; PG8_SCHED;
        }
        if (wr == 0) PG8_BAR;
        E(acc, cur, ui, wr, wc, fr, fq);
        if (!has_next) break;
#pragma unroll
        for (int a = 0; a < 2; ++a)
#pragma unroll
            for (int b = 0; b < 2; ++b)
#pragma unroll
                for (int m = 0; m < 4; ++m)
#pragma unroll
                    for (int n = 0; n < 2; ++n) acc[a][b][m][n] = (f32x4){0.f, 0.f, 0.f, 0.f};
        cur = nxt; cA = nA; cB = nB; ++ui;
        if (wr == 1) PG8_BAR;
    }
    PG8_WAIT_V(0);
    PG8_BAR;
#undef PG8_SA
#undef PG8_SB
#undef PG8_STAGE
#undef PG8_LDA
#undef PG8_LDB
#undef PG8_MMA
#undef PG8_WAIT_V
#undef PG8_WAIT_L
#undef PG8_BAR
#undef PG8_SCHED
}

__device__ __forceinline__ void st_bf16x4(bf16_t* p, const f32x4 v) { u32x2 w; w.x = cvt_pk_bf16(v[0], v[1]); w.y = cvt_pk_bf16(v[2], v[3]); *(u32x2*)p = w; }

__device__ __forceinline__ float dpp_ror1(float v) { return __builtin_bit_cast(float, __builtin_amdgcn_update_dpp(0, __builtin_bit_cast(int, v), 0x121, 0xf, 0xf, false)); }
__device__ __forceinline__ float dpp_ror2(float v) { return __builtin_bit_cast(float, __builtin_amdgcn_update_dpp(0, __builtin_bit_cast(int, v), 0x122, 0xf, 0xf, false)); }
struct Epi1 {
    static constexpr bool PERM = false, AMAP = true;
    bf16_t* Y; const float* convw; float* VL; float* G; float* YP; LAS float* hal;
    __device__ __forceinline__ void operator()(f32x4 (&acc)[2][2][4][2], const Unit& u, int ui, int wr, int wc, int fr, int fq) const {
        const int ch = u.pn * 64 + wc * 16 + 8 * (fq & 1) + 4 * (fq >> 1);
        const f32x4 w0 = *(const f32x4*)(convw + ch), w1 = *(const f32x4*)(convw + 1024 + ch), w2 = *(const f32x4*)(convw + 2048 + ch);
#pragma unroll
        for (int ai = 0; ai < 2; ++ai)
#pragma unroll
            for (int m = 0; m < 4; ++m) {
                const f32x4 Bv = acc[ai][0][m][0], Cv = acc[ai][0][m][1], Uv = acc[ai][1][m][0], Zv = acc[ai][1][m][1];
                f32x4 gt, v;
#pragma unroll
                for (int j = 0; j < 4; ++j) { gt[j] = Bv[j] * silu_f(Zv[j]); v[j] = Cv[j] * Uv[j]; }
                acc[ai][0][m][0] = gt; acc[ai][0][m][1] = v;
            }
        LAS float* hp = hal + (fr & 1) * 64 + wc * 16 + fq * 4;
        f32x4 vprev = (f32x4){0.f, 0.f, 0.f, 0.f};
        if (wr == 0 && fr >= 14) *(LAS f32x4*)hp = acc[1][0][3][1];
        asm volatile("s_waitcnt lgkmcnt(0)" ::: "memory"); __builtin_amdgcn_s_barrier(); asm volatile("" ::: "memory");
        if (wr == 1 && fr >= 14) vprev = *(const LAS f32x4*)hp;
#pragma unroll
        for (int ai = 0; ai < 2; ++ai)
#pragma unroll
            for (int mp = 0; mp < 2; ++mp) {
                unsigned yp[2][2];
#pragma unroll
                for (int mm = 0; mm < 2; ++mm) {
                    const int m = 2 * mp + mm;
                    const f32x4 vc = acc[ai][0][m][1], gt = acc[ai][0][m][0];
                    f32x4 y;
#pragma unroll
                    for (int j = 0; j < 4; ++j) {
                        const float c1 = (fr == 15) ? vprev[j] : vc[j], c2 = (fr >= 14) ? vprev[j] : vc[j];
                        const float vm1 = dpp_ror1(c1), vm2 = dpp_ror2(c2);
                        y[j] = gt[j] * (w0[j] * vm2 + w1[j] * vm1 + w2[j] * vc[j]);
                    }
                    yp[mm][0] = cvt_pk_bf16(y[0], y[1]); yp[mm][1] = cvt_pk_bf16(y[2], y[3]);
                    if (wr == 0 && ai == 0 && m == 0 && fr < 2) { *(f32x4*)(G + (size_t)(u.pm * 2 + fr) * D_ + ch) = gt; *(f32x4*)(YP + (size_t)(u.pm * 2 + fr) * D_ + ch) = y; }
                    if (wr == 1 && ai == 1 && m == 3 && fr >= 14) *(f32x4*)(VL + (size_t)(u.pm * 2 + fr - 14) * D_ + ch) = vc;
                    vprev = vc;
                }
                { auto r0 = __builtin_amdgcn_permlane32_swap(yp[0][0], yp[1][0], false, false); auto r1 = __builtin_amdgcn_permlane32_swap(yp[0][1], yp[1][1], false, false);
                  const int row = u.pm * BM + wr * HALF + ai * 64 + (2 * mp + (fq >> 1)) * 16 + fr;
                  *(u32x4*)(Y + (size_t)row * D_ + u.pn * 64 + wc * 16 + 8 * (fq & 1)) = (u32x4){r0[0], r1[0], r0[1], r1[1]}; }
            }
    }
};
__device__ __forceinline__ void st_bf16x8(bf16_t* p, const f32x4 v0, const f32x4 v1) { u32x4 w; w.x = cvt_pk_bf16(v0[0], v0[1]); w.y = cvt_pk_bf16(v0[2], v0[3]); w.z = cvt_pk_bf16(v1[0], v1[1]); w.w = cvt_pk_bf16(v1[2], v1[3]); *(u32x4*)p = w; }
struct Epi2 {
    static constexpr bool PERM = true, AMAP = false;
    bf16_t* HX; float* SSQ; const LAS float* irs_tab; const LAS float* invg;
    __device__ __forceinline__ void operator()(f32x4 (&acc)[2][2][4][2], const Unit& u, int ui, int wr, int wc, int fr, int fq) const {
        const int rl0 = wr * 64 + fr, row0 = u.pm * BM + rl0, col0 = u.pn * BM + wc * 32 + 8 * fq;
        f32x4 ig[2][2];
#pragma unroll
        for (int bj = 0; bj < 2; ++bj)
#pragma unroll
            for (int n = 0; n < 2; ++n) ig[bj][n] = *(const LAS f32x4*)(invg + col0 + bj * HALF + 4 * n);
        {
            u32x4 hb[16];
#define EPI2_LOAD(k) hb[k] = *(const u32x4*)(HX + (size_t)(row0 + ((k) >> 3) * HALF + (((k) >> 1) & 3) * 16) * D_ + col0 + ((k) & 1) * HALF)
#pragma unroll
            for (int k = 0; k < 8; ++k) EPI2_LOAD(k);
#pragma unroll
            for (int k = 0; k < 16; ++k) {
                if (k + 8 < 16) EPI2_LOAD(k + 8);
                const int ai = k >> 3, m = (k >> 1) & 3, bj = k & 1;
                const float irs = irs_tab[ui * 256 + rl0 + ai * HALF + m * 16];
                const u32x4 w = hb[k];
                const f32x4 h0 = (f32x4){__uint_as_float(w.x << 16), __uint_as_float(w.x & 0xffff0000u), __uint_as_float(w.y << 16), __uint_as_float(w.y & 0xffff0000u)};
                const f32x4 h1 = (f32x4){__uint_as_float(w.z << 16), __uint_as_float(w.z & 0xffff0000u), __uint_as_float(w.w << 16), __uint_as_float(w.w & 0xffff0000u)};
                acc[ai][bj][m][0] += h0 * ig[bj][0] * irs; acc[ai][bj][m][1] += h1 * ig[bj][1] * irs;
                asm volatile("" : "+v"(acc[ai][bj][m][0]), "+v"(acc[ai][bj][m][1]));
                __builtin_amdgcn_sched_barrier(0);
            }
#undef EPI2_LOAD
            asm volatile("" ::: "memory"); __builtin_amdgcn_sched_barrier(0);
        }
#pragma unroll
        for (int ai = 0; ai < 2; ++ai)
#pragma unroll
            for (int m = 0; m < 4; ++m) {
                const int row = row0 + ai * HALF + m * 16; float ss = 0.f;
#pragma unroll
                for (int bj = 0; bj < 2; ++bj) {
                    const f32x4 o0 = acc[ai][bj][m][0], o1 = acc[ai][bj][m][1];
                    st_bf16x8(HX + (size_t)row * D_ + col0 + bj * HALF, o0, o1);
                    ss += ((o0[0] * o0[0] + o0[1] * o0[1]) + (o0[2] * o0[2] + o0[3] * o0[3])) + ((o1[0] * o1[0] + o1[1] * o1[1]) + (o1[2] * o1[2] + o1[3] * o1[3]));
                }
                ss += __shfl_xor(ss, 16); ss += __shfl_xor(ss, 32);
                if (fq == 0) SSQ[(size_t)row * 16 + u.pn * 4 + wc] = ss;
            }
    }
};
struct Epi3 {
    static constexpr bool PERM = true, AMAP = false;
    const LAS float* rstd_tab; const LAS float* ropeR; const LAS float* gains; const float* ropeB; bf16_t* KB; bf16_t* VB; bf16_t* QB; bf16_t* ZB;
    __device__ __forceinline__ void operator()(f32x4 (&acc)[2][2][4][2], const Unit& u, int ui, int wr, int wc, int fr, int fq) const {
        const int pn = u.pn;
        const bool isk = (pn == 0), isq = (pn >= 2 && pn < 6);
        const int rl0 = wr * 64 + fr;
        if (isk || isq) {
            const LAS float* gp = gains + (isk ? 0 : 64);
            f32x4 gn[2][2];
#pragma unroll
            for (int bj = 0; bj < 2; ++bj)
#pragma unroll
                for (int n = 0; n < 2; ++n) gn[bj][n] = *(const LAS f32x4*)(gp + 32 * bj + 8 * fq + 4 * n);
            const float* rb = ropeB + (u.pm & 31) * 16;
            f32x4 cB[2], sB[2];
#pragma unroll
            for (int n = 0; n < 2; ++n) { cB[n] = *(const f32x4*)(rb + 4 * n); sB[n] = *(const f32x4*)(rb + 8 + 4 * n); }
            bf16_t* dst0; int ld;
            if (isk) { dst0 = KB + wc * 64; ld = 256; } else { dst0 = QB + (pn - 2) * 256 + wc * 64; ld = D_; }
#pragma unroll
            for (int ai = 0; ai < 2; ++ai)
#pragma unroll
                for (int m = 0; m < 4; ++m) {
                    const int rl = rl0 + ai * HALF + m * 16;
                    const float rstd = rstd_tab[ui * 256 + rl];
                    f32x4 v[2][2]; float ss = 0.f;
#pragma unroll
                    for (int bj = 0; bj < 2; ++bj)
#pragma unroll
                        for (int n = 0; n < 2; ++n) { v[bj][n] = acc[ai][bj][m][n] * rstd; ss += (v[bj][n][0] * v[bj][n][0] + v[bj][n][1] * v[bj][n][1]) + (v[bj][n][2] * v[bj][n][2] + v[bj][n][3] * v[bj][n][3]); }
                    ss += __shfl_xor(ss, 16); ss += __shfl_xor(ss, 32);
                    float rs = rsqrtf(ss * (1.0f / 64.0f) + EPS_);
                    if (isq) rs *= 0.18033688011112042f;
#pragma unroll
                    for (int bj = 0; bj < 2; ++bj)
#pragma unroll
                        for (int n = 0; n < 2; ++n) v[bj][n] = v[bj][n] * rs * gn[bj][n];
#pragma unroll
                    for (int n = 0; n < 2; ++n) {
                        const f32x4 cA = *(const LAS f32x4*)(ropeR + rl * 16 + 4 * n), sA = *(const LAS f32x4*)(ropeR + rl * 16 + 8 + 4 * n);
                        const f32x4 cs = cA * cB[n] - sA * sB[n], sn = sA * cB[n] + cA * sB[n];
#pragma unroll
                        for (int j = 0; j < 4; ++j) {
                            const float me = v[0][n][j], pr = __shfl_xor(me, 16);
                            const float ro = (fq == 0) ? (me * cs[j] - pr * sn[j]) : (me * cs[j] + pr * sn[j]);
                            v[0][n][j] = (fq < 2) ? ro : me;
                        }
                    }
                    bf16_t* dst = dst0 + (size_t)(u.pm * BM + rl) * ld + 8 * fq;
#pragma unroll
                    for (int bj = 0; bj < 2; ++bj) st_bf16x8(dst + 32 * bj, v[bj][0], v[bj][1]);
                }
        } else {
            bf16_t* dst0; int ld;
            if (pn == 1) { dst0 = VB + wc * 64; ld = 256; } else { dst0 = ZB + (pn - 6) * 256 + wc * 64; ld = D_; }
            const bool act = (pn != 1);
#pragma unroll
            for (int ai = 0; ai < 2; ++ai)
#pragma unroll
                for (int m = 0; m < 4; ++m) {
                    const float rstd = rstd_tab[ui * 256 + rl0 + ai * HALF + m * 16];
                    bf16_t* dst = dst0 + (size_t)(u.pm * BM + rl0 + ai * HALF + m * 16) * ld + 8 * fq;
#pragma unroll
                    for (int bj = 0; bj < 2; ++bj) {
                        f32x4 v0 = acc[ai][bj][m][0] * rstd, v1 = acc[ai][bj][m][1] * rstd;
                        if (act) {
#pragma unroll
                            for (int j = 0; j < 4; ++j) { v0[j] = silu_f(v0[j]); v1[j] = silu_f(v1[j]); }
                        }
                        st_bf16x8(dst + 32 * bj, v0, v1);
                    }
                }
        }
    }
};
struct Epi4 {
    static constexpr bool PERM = true, AMAP = false;
    const bf16_t* X1B; float* O;
    __device__ __forceinline__ void operator()(f32x4 (&acc)[2][2][4][2], const Unit& u, int ui, int wr, int wc, int fr, int fq) const {
        const int row0 = u.pm * BM + wr * 64 + fr, col0 = u.pn * BM + wc * 32 + 8 * fq;
        {
            u32x4 xb[2][4][2];
#pragma unroll
            for (int ai = 0; ai < 2; ++ai)
#pragma unroll
                for (int m = 0; m < 4; ++m)
#pragma unroll
                    for (int bj = 0; bj < 2; ++bj) xb[ai][m][bj] = *(const u32x4*)(X1B + (size_t)(row0 + ai * HALF + m * 16) * D_ + col0 + bj * HALF);
#pragma unroll
            for (int ai = 0; ai < 2; ++ai)
#pragma unroll
                for (int m = 0; m < 4; ++m)
#pragma unroll
                    for (int bj = 0; bj < 2; ++bj) {
                        const u32x4 w = xb[ai][m][bj];
                        acc[ai][bj][m][0] += (f32x4){__uint_as_float(w.x << 16), __uint_as_float(w.x & 0xffff0000u), __uint_as_float(w.y << 16), __uint_as_float(w.y & 0xffff0000u)};
                        acc[ai][bj][m][1] += (f32x4){__uint_as_float(w.z << 16), __uint_as_float(w.z & 0xffff0000u), __uint_as_float(w.w << 16), __uint_as_float(w.w & 0xffff0000u)};
                        asm volatile("" : "+v"(acc[ai][bj][m][0]), "+v"(acc[ai][bj][m][1]));
                    }
            asm volatile("" ::: "memory"); __builtin_amdgcn_sched_barrier(0);
        }
#pragma unroll
        for (int ai = 0; ai < 2; ++ai)
#pragma unroll
            for (int m = 0; m < 4; ++m)
#pragma unroll
                for (int bj = 0; bj < 2; ++bj) {
                    float* p = O + (size_t)(row0 + ai * HALF + m * 16) * D_ + col0 + bj * HALF;
                    *(f32x4*)p = acc[ai][bj][m][0]; *(f32x4*)(p + 4) = acc[ai][bj][m][1];
                }
    }
};

__device__ __forceinline__ void sincos_d(double a, float& c, float& s) {
    const double q = rint(a * 0.63661977236758134308);
    double r = fma(-q, 1.57079632679489655800, a); r = fma(-q, 6.12323399573676603587e-17, r);
    const double r2 = r * r;
    double sp = -7.6471637318198164759e-13; sp = fma(sp, r2, 1.6059043836821614599e-10); sp = fma(sp, r2, -2.5052108385441718775e-8); sp = fma(sp, r2, 2.7557319223985890653e-6);
    sp = fma(sp, r2, -1.9841269841269841270e-4); sp = fma(sp, r2, 8.3333333333333333333e-3); sp = fma(sp, r2, -1.6666666666666666667e-1);
    const double sr = fma(r * r2, sp, r);
    double cp = 4.7794773323873852974e-14; cp = fma(cp, r2, -1.1470745597729724714e-11); cp = fma(cp, r2, 2.0876756987868098979e-9); cp = fma(cp, r2, -2.7557319223985890653e-7);
    cp = fma(cp, r2, 2.4801587301587301587e-5); cp = fma(cp, r2, -1.3888888888888888889e-3); cp = fma(cp, r2, 4.1666666666666666667e-2); cp = fma(cp, r2, -0.5);
    const double cr = fma(r2, cp, 1.0);
    const int qi = ((int)q) & 3;
    const double sv = (qi == 0) ? sr : (qi == 1) ? cr : (qi == 2) ? -sr : -cr;
    const double cv = (qi == 0) ? cr : (qi == 1) ? -sr : (qi == 2) ? -cr : sr;
    c = (float)cv; s = (float)sv;
}

__device__ __forceinline__ void phase0(const Args& a, LAS unsigned char* lds) {
    const int tid = threadIdx.x, G = gridDim.x, wid = tid >> 6, lane = tid & 63;
    const int gw = blockIdx.x * 8 + wid, NW = G * 8;
    unsigned char* ws = a.ws;
    { float* rope = (float*)(ws + WS_ROPE);
      for (int e = blockIdx.x * 512 + tid; e < 288 * 8; e += G * 512) {
          const int q = e >> 3, i = e & 7; const float iv = (i == 0) ? a.inv0 : (i == 1) ? a.inv1 : (i == 2) ? a.inv2 : (i == 3) ? a.inv3 : (i == 4) ? a.inv4 : (i == 5) ? a.inv5 : (i == 6) ? a.inv6 : a.inv7;
          const int pos = (q < 256) ? q : (q - 256) * 256; float c, s; sincos_d((double)pos * (double)iv, c, s);
          rope[q * 16 + i] = c; rope[q * 16 + 8 + i] = s; } }
    { bf16_t* WT = (bf16_t*)(ws + WS_WT);
      LAS unsigned char* tile = lds + wid * 8448;
      for (int t = gw; t < (WROWS / 64) * 16; t += NW) {
          const int n0 = (t >> 4) * 64, k0 = (t & 15) * 64;
          const int np = n0 + lane;
          const float* W; int ld, col; const float* gain = nullptr;
          if (np < WROW2) { const int pn = np >> 8, ct = np & 255, bj = ct >> 7, wc = (ct >> 5) & 3, n = (ct >> 4) & 1, cc = ct & 15; W = a.w_in_a; ld = 4096; col = (2 * bj + n) * 1024 + 64 * pn + 16 * wc + (8 * ((cc >> 2) & 1) + 4 * (cc >> 3) + (cc & 3)); }
          else if (np < WROW3) { W = a.w_out_a; ld = 1024; col = np - WROW2; }
          else if (np < WROW4) { const int n3 = np - WROW3, pn = n3 >> 8, ct = n3 & 255, bj = ct >> 7, wc = (ct >> 5) & 3, cc = ct & 31; const int oc = 256 * pn + 64 * wc + 32 * bj + cc;
              if (oc < 512) { W = a.w_kv; ld = 512; col = oc; gain = a.ln_kv; } else { W = a.w_in_b; ld = 2048; col = oc - 512; gain = a.ln_b; } }
          else { W = a.w_out_b; ld = 1024; col = np - WROW4; }
          const float* src = W + (size_t)k0 * ld + col;
#pragma unroll
          for (int kb = 0; kb < 64; kb += 16) {
              float v[16];
#pragma unroll
              for (int i = 0; i < 16; ++i) v[i] = __builtin_nontemporal_load(src + (size_t)(kb + i) * ld);
              if (gain) {
#pragma unroll
                  for (int i = 0; i < 16; ++i) v[i] *= gain[k0 + kb + i];
              }
#pragma unroll
              for (int i = 0; i < 8; ++i) *(LAS unsigned*)(tile + lane * 132 + (kb + 2 * i) * 2) = cvt_pk_bf16(v[2 * i], v[2 * i + 1]);
          }
          asm volatile("s_waitcnt lgkmcnt(0)" ::: "memory");
#pragma unroll
          for (int it = 0; it < 8; ++it) {
              const int nl = it * 8 + (lane >> 3), k8 = (lane & 7) * 8;
              const LAS unsigned* rp = (const LAS unsigned*)(tile + nl * 132 + k8 * 2);
              u32x4 o; o.x = rp[0]; o.y = rp[1]; o.z = rp[2]; o.w = rp[3];
              *(u32x4*)(WT + (size_t)(n0 + nl) * D_ + k0 + k8) = o;
          }
          asm volatile("s_waitcnt lgkmcnt(0)" ::: "memory");
      } }
    { bf16_t* HB = (bf16_t*)(ws + WS_R0);
      f32x4 gv[4];
#pragma unroll
      for (int i = 0; i < 4; ++i) gv[i] = *(const f32x4*)(a.ln_a + i * 256 + lane * 4);
      for (int row = gw * 2; row < M_; row += NW * 2) {
          f32x4 xv[2][4];
#pragma unroll
          for (int rr = 0; rr < 2; ++rr)
#pragma unroll
              for (int i = 0; i < 4; ++i) xv[rr][i] = __builtin_nontemporal_load((const f32x4*)(a.x + (size_t)(row + rr) * D_ + i * 256 + lane * 4));
#pragma unroll
          for (int rr = 0; rr < 2; ++rr) {
              float ss = 0.f;
#pragma unroll
              for (int i = 0; i < 4; ++i) ss += (xv[rr][i][0] * xv[rr][i][0] + xv[rr][i][1] * xv[rr][i][1]) + (xv[rr][i][2] * xv[rr][i][2] + xv[rr][i][3] * xv[rr][i][3]);
#pragma unroll
              for (int o = 32; o >= 1; o >>= 1) ss += __shfl_xor(ss, o);
              const float ms = ss * (1.0f / 1024.0f) + EPS_;
              const float rstd = rsqrtf(ms);
              if (lane == 0) ((float*)(ws + WS_RSTD0))[row + rr] = sqrtf(ms);
#pragma unroll
              for (int i = 0; i < 4; ++i) st_bf16x4(HB + (size_t)(row + rr) * D_ + i * 256 + lane * 4, xv[rr][i] * rstd * gv[i]);
          }
      } }
    __syncthreads();
}

__device__ __forceinline__ void patch_y(const Args& a, int pm) {
    if ((pm & 31) == 0) return;
    unsigned char* ws = a.ws; const int tid = threadIdx.x, r = tid >> 8, c4 = (tid & 255) * 4;
    const float* VL = (const float*)(ws + WS_VL); const float* Gp = (const float*)(ws + WS_G); const float* YP = (const float*)(ws + WS_YP);
    const f32x4 yp = *(const f32x4*)(YP + (size_t)(pm * 2 + r) * D_ + c4), gt = *(const f32x4*)(Gp + (size_t)(pm * 2 + r) * D_ + c4);
    const f32x4 vl0 = *(const f32x4*)(VL + (size_t)((pm - 1) * 2 + 0) * D_ + c4), vl1 = *(const f32x4*)(VL + (size_t)((pm - 1) * 2 + 1) * D_ + c4);
    const f32x4 w0 = *(const f32x4*)(a.conv_a + c4), w1 = *(const f32x4*)(a.conv_a + 1024 + c4);
    const f32x4 add = (r == 0) ? (w0 * vl0 + w1 * vl1) : (w0 * vl1);
    st_bf16x4((bf16_t*)(ws + WS_R1) + (size_t)(pm * BM + r) * D_ + c4, yp + gt * add);
}

constexpr int KS_STRIDE = 144, VT_OFF = 256 * KS_STRIDE, VT_STRIDE = 528, ATT_BUF = VT_OFF + 64 * VT_STRIDE;
static_assert(2 * ATT_BUF <= XBST_OFF, "attention double buffer must stay below the barrier's LDS words");
__device__ __forceinline__ void attn_load_k(const bf16_t* KB, int it, int tid, u32x4 (&kr)[4]) {
    const int kvh = it & 3, blk = (it >> 2) & 63, b = it >> 8, t0 = b * SEQ_ + blk * 128;
    const bf16_t* p = KB + (size_t)(t0 - 128) * 256 + kvh * 64 + (tid >> 3) * 256 + (tid & 7) * 8;
#pragma unroll
    for (int i = 0; i < 4; ++i) { kr[i] = (u32x4){0u, 0u, 0u, 0u}; if (blk > 0 || i >= 2) kr[i] = *(const u32x4*)(p + i * 64 * 256); }
}
__device__ __forceinline__ void attn_load_v(const bf16_t* VB, int it, int tid, u32x4 (&vr)[4]) {
    const int kvh = it & 3, blk = (it >> 2) & 63, b = it >> 8, t0 = b * SEQ_ + blk * 128;
    const bf16_t* p = VB + (size_t)(t0 - 128) * 256 + kvh * 64 + (tid >> 3) * 512 + (tid & 7) * 8;
#pragma unroll
    for (int i = 0; i < 2; ++i)
#pragma unroll
        for (int kk = 0; kk < 2; ++kk) { vr[i * 2 + kk] = (u32x4){0u, 0u, 0u, 0u}; if (blk > 0 || i >= 1) vr[i * 2 + kk] = *(const u32x4*)(p + i * 128 * 256 + kk * 256); }
}
__device__ __forceinline__ void attn_store_k(LAS unsigned char* buf, int tid, const u32x4 (&kr)[4]) {
    LAS unsigned char* p = buf + (tid >> 3) * KS_STRIDE + (tid & 7) * 16;
#pragma unroll
    for (int i = 0; i < 4; ++i) *(LAS u32x4*)(p + i * 64 * KS_STRIDE) = kr[i];
}
__device__ __forceinline__ void attn_store_v(LAS unsigned char* buf, int tid, const u32x4 (&vr)[4]) {
    const int key0 = 2 * (tid >> 3), k16 = key0 & 15;
    const int pos = (key0 & ~15) | (8 * ((k16 >> 2) & 1) + 4 * (k16 >> 3) + (k16 & 3));
    LAS unsigned char* p = buf + VT_OFF + ((tid & 7) * 8) * VT_STRIDE + pos * 2;
#pragma unroll
    for (int i = 0; i < 2; ++i) {
        const u32x4 va = vr[i * 2], vb = vr[i * 2 + 1];
#pragma unroll
        for (int e2 = 0; e2 < 4; ++e2) {
            *(LAS unsigned*)(p + i * 256 + (2 * e2) * VT_STRIDE) = (va[e2] & 0xffffu) | (vb[e2] << 16);
            *(LAS unsigned*)(p + i * 256 + (2 * e2 + 1) * VT_STRIDE) = (va[e2] >> 16) | (vb[e2] & 0xffff0000u);
        }
    }
}
__device__ __forceinline__ void attn_load_q(const bf16_t* QB, int it, int wid, int sb, int r, int h, bf16x8 (&qf)[4]) {
    const int kvh = it & 3, blk = (it >> 2) & 63, b = it >> 8, t0 = b * SEQ_ + blk * 128, a0 = (wid & 1) * 64 + sb * 32, hq = kvh * 4 + (wid >> 1);
    const bf16_t* qp = QB + (size_t)(t0 + a0 + r) * D_ + hq * 64 + 8 * h;
#pragma unroll
    for (int kk = 0; kk < 4; ++kk) qf[kk] = *(const bf16x8*)(qp + 16 * kk);
}
__device__ __forceinline__ void attn_sub(const LAS unsigned char* buf, const bf16x8 (&qf)[4], const bf16_t* ZB, bf16_t* OG, int t0, int a0, int blk, int hq, float sink2, int r, int h) {
    const int kt0 = a0 >> 5;
    const size_t rowoff = (size_t)(t0 + a0 + r) * D_ + hq * 64;
    u32x4 zq[2][2];
#pragma unroll
    for (int db = 0; db < 2; ++db)
#pragma unroll
        for (int pr = 0; pr < 2; ++pr) zq[db][pr] = *(const u32x4*)(ZB + rowoff + 32 * db + 16 * pr + 8 * h);
    f32x16 S[5];
#pragma unroll
    for (int t = 0; t < 5; ++t) {
#pragma unroll
        for (int i = 0; i < 16; ++i) S[t][i] = 0.f;
#pragma unroll
        for (int kk = 0; kk < 4; ++kk) { const bf16x8 kf = *(const LAS bf16x8*)(buf + (32 * (kt0 + t) + r) * KS_STRIDE + (16 * kk + 8 * h) * 2); S[t] = __builtin_amdgcn_mfma_f32_32x32x16_bf16(kf, qf[kk], S[t], 0, 0, 0); }
    }
    const int rr = r - 4 * h;
#pragma unroll
    for (int i = 0; i < 16; ++i) { const int ci = (i & 3) + 8 * (i >> 2); S[0][i] = (ci > rr) ? S[0][i] : -1e30f; S[4][i] = (ci <= rr) ? S[4][i] : -1e30f; }
    if (blk == 0) {
#pragma unroll
        for (int t = 0; t < 4; ++t) if (kt0 + t < 4) {
#pragma unroll
            for (int i = 0; i < 16; ++i) S[t][i] = -1e30f; }
    }
    float mx = sink2;
#pragma unroll
    for (int t = 0; t < 5; ++t)
#pragma unroll
        for (int i = 0; i < 16; ++i) mx = fmaxf(mx, S[t][i]);
    { auto rr = __builtin_amdgcn_permlane32_swap(__float_as_uint(mx), __float_as_uint(mx), false, false); mx = fmaxf(__uint_as_float(rr[0]), __uint_as_float(rr[1])); }
    float sum = 0.f;
#pragma unroll
    for (int t = 0; t < 5; ++t)
#pragma unroll
        for (int i = 0; i < 16; ++i) { const float p = __builtin_amdgcn_exp2f(S[t][i] - mx); S[t][i] = p; sum += p; }
    { auto rr = __builtin_amdgcn_permlane32_swap(__float_as_uint(sum), __float_as_uint(sum), false, false); sum = __uint_as_float(rr[0]) + __uint_as_float(rr[1]); }
    sum += __builtin_amdgcn_exp2f(sink2 - mx);
    const float inv = __builtin_amdgcn_rcpf(sum);
    f32x16 O[2];
#pragma unroll
    for (int db = 0; db < 2; ++db)
#pragma unroll
        for (int i = 0; i < 16; ++i) O[db][i] = 0.f;
#pragma unroll
    for (int t = 0; t < 5; ++t)
#pragma unroll
        for (int s = 0; s < 2; ++s) {
            u32x4 pk; pk.x = cvt_pk_bf16(S[t][8 * s + 0], S[t][8 * s + 1]); pk.y = cvt_pk_bf16(S[t][8 * s + 2], S[t][8 * s + 3]); pk.z = cvt_pk_bf16(S[t][8 * s + 4], S[t][8 * s + 5]); pk.w = cvt_pk_bf16(S[t][8 * s + 6], S[t][8 * s + 7]);
            const bf16x8 pf = __builtin_bit_cast(bf16x8, pk);
#pragma unroll
            for (int db = 0; db < 2; ++db) { const bf16x8 vf = *(const LAS bf16x8*)(buf + VT_OFF + (32 * db + r) * VT_STRIDE + (32 * (kt0 + t) + 16 * s + 8 * h) * 2); O[db] = __builtin_amdgcn_mfma_f32_32x32x16_bf16(vf, pf, O[db], 0, 0, 0); }
        }
#pragma unroll
    for (int db = 0; db < 2; ++db)
#pragma unroll
        for (int pr = 0; pr < 2; ++pr) {
            u32x4 z4 = zq[db][pr];
            { auto r0 = __builtin_amdgcn_permlane32_swap(z4.x, z4.z, false, false); auto r1 = __builtin_amdgcn_permlane32_swap(z4.y, z4.w, false, false); z4.x = r0[0]; z4.z = r0[1]; z4.y = r1[0]; z4.w = r1[1]; }
            const int ia = 8 * pr, ib = 8 * pr + 4;
            unsigned a0 = cvt_pk_bf16(O[db][ia + 0] * inv * __uint_as_float(z4.x << 16), O[db][ia + 1] * inv * __uint_as_float(z4.x & 0xffff0000u));
            unsigned a1 = cvt_pk_bf16(O[db][ia + 2] * inv * __uint_as_float(z4.y << 16), O[db][ia + 3] * inv * __uint_as_float(z4.y & 0xffff0000u));
            unsigned b0 = cvt_pk_bf16(O[db][ib + 0] * inv * __uint_as_float(z4.z << 16), O[db][ib + 1] * inv * __uint_as_float(z4.z & 0xffff0000u));
            unsigned b1 = cvt_pk_bf16(O[db][ib + 2] * inv * __uint_as_float(z4.w << 16), O[db][ib + 3] * inv * __uint_as_float(z4.w & 0xffff0000u));
            { auto r0 = __builtin_amdgcn_permlane32_swap(a0, b0, false, false); auto r1 = __builtin_amdgcn_permlane32_swap(a1, b1, false, false); a0 = r0[0]; b0 = r0[1]; a1 = r1[0]; b1 = r1[1]; }
            *(u32x4*)(OG + rowoff + 32 * db + 16 * pr + 8 * h) = (u32x4){a0, a1, b0, b1};
        }
}
__device__ __forceinline__ void attn_phase(const Args& a, LAS unsigned char* lds) {
    const int tid = threadIdx.x, wid = tid >> 6, lane = tid & 63, r = lane & 31, h = lane >> 5, G = gridDim.x;
    unsigned char* ws = a.ws;
    const bf16_t* KB = (const bf16_t*)(ws + WS_KB); const bf16_t* VB = (const bf16_t*)(ws + WS_VB); const bf16_t* QB = (const bf16_t*)(ws + WS_R1);
    const bf16_t* ZB = (const bf16_t*)(ws + WS_ZB); bf16_t* OG = (bf16_t*)(ws + WS_OG);
    u32x4 kr[4], vr[4];
    bf16x8 qa[4], qb[4];
    int it = blockIdx.x;
    if (it < 1024) { attn_load_k(KB, it, tid, kr); attn_load_v(VB, it, tid, vr); attn_load_q(QB, it, wid, 0, r, h, qa); attn_store_k(lds, tid, kr); attn_store_v(lds, tid, vr); }
    __syncthreads();
    for (int n = 0; it < 1024; it += G, ++n) {
        const LAS unsigned char* buf = lds + (n & 1) * ATT_BUF; LAS unsigned char* nbuf = lds + ((n + 1) & 1) * ATT_BUF;
        const int kvh = it & 3, blk = (it >> 2) & 63, b = it >> 8, t0 = b * SEQ_ + blk * 128;
        const bool hasn = (it + G) < 1024;
        if (hasn) attn_load_k(KB, it + G, tid, kr);
        attn_load_q(QB, it, wid, 1, r, h, qb);
        const int g = wid >> 1, hq = kvh * 4 + g; const float sink2 = a.sinks[hq] * 1.4426950408889634f;
        attn_sub(buf, qa, ZB, OG, t0, (wid & 1) * 64, blk, hq, sink2, r, h);
        if (hasn) { attn_store_k(nbuf, tid, kr); attn_load_v(VB, it + G, tid, vr); attn_load_q(QB, it + G, wid, 0, r, h, qa); }
        attn_sub(buf, qb, ZB, OG, t0, (wid & 1) * 64 + 32, blk, hq, sink2, r, h);
        if (hasn) attn_store_v(nbuf, tid, vr);
        __syncthreads();
    }
}

#define XB_TMO      128
#define XB_XCNT(j)  (256  + 64 * (j))
#define XB_XSUB(j)  (1280 + 64 * (j))
#define XB_XGEN(j)  (2304 + 64 * (j))
#define XB_TOP      3328
#define XB_TOPGEN   3392
#define XCD_BAR_WORDS 3456
#define XB_SPIN_CAP (1u << 18)
__device__ __forceinline__ unsigned xb_ld(unsigned* p)              { return __hip_atomic_load(p, __ATOMIC_RELAXED, __HIP_MEMORY_SCOPE_AGENT); }
__device__ __forceinline__ unsigned xb_add(unsigned* p, unsigned v) { return __hip_atomic_fetch_add(p, v, __ATOMIC_RELAXED, __HIP_MEMORY_SCOPE_AGENT); }
__device__ __forceinline__ unsigned xb_xcc_id() { return (unsigned)__builtin_amdgcn_s_getreg((3 << 11) | 20) & 0xFu; }
#define XB_SPIN(cond, bar) do { unsigned _sp = 0; while (cond) { __builtin_amdgcn_s_sleep(1); \
    if ((++_sp & 255u) == 0u) { if (xb_ld(&(bar)[XB_TMO])) break; if (_sp > XB_SPIN_CAP) { atomicAdd(&(bar)[XB_TMO], 1u); break; } } } } while (0)
struct XcdBarrier { unsigned* bar; unsigned x; volatile LAS unsigned* st; };
__device__ __forceinline__ XcdBarrier xcd_barrier_post(unsigned* bar, volatile LAS unsigned* st) {
    XcdBarrier b; b.bar = bar; b.x = xb_xcc_id(); b.st = st;
    if (threadIdx.x == 0) (void)xb_add(&bar[XB_XCNT(b.x)], 1u);
    return b;
}
__device__ __forceinline__ void xcd_barrier_complete(unsigned* bar, unsigned x, unsigned& nloc, unsigned& nx) {
    const unsigned G = gridDim.x * gridDim.y * gridDim.z;
    unsigned sum, cnt, mine, sp = 0u;
    for (;;) {
        sum = 0u; cnt = 0u; mine = 0u;
#pragma unroll
        for (unsigned j = 0; j < 16; ++j) { const unsigned c = xb_ld(&bar[XB_XCNT(j)]); sum += c; cnt += (c > 0u) ? 1u : 0u; mine = (j == x) ? c : mine; }
        if (sum == G) break;
        __builtin_amdgcn_s_sleep(1);
        if ((++sp & 255u) == 0u) { if (xb_ld(&bar[XB_TMO])) break; if (sp > XB_SPIN_CAP) { atomicAdd(&bar[XB_TMO], 1u); break; } }
    }
    nloc = mine > 0u ? mine : 1u; nx = cnt > 0u ? cnt : 1u;
}
__device__ __forceinline__ void xcd_barrier(const XcdBarrier& b) {
    asm volatile("s_waitcnt vmcnt(0)" ::: "memory");
    __syncthreads();
    if (threadIdx.x == 0) {
        unsigned* bar = b.bar;
        __builtin_amdgcn_s_waitcnt(0);
        unsigned nloc = b.st[0], nx = b.st[1];
        if (nloc == 0u) { xcd_barrier_complete(bar, b.x, nloc, nx); b.st[0] = nloc; b.st[1] = nx; }
        const unsigned old = xb_add(&bar[XB_XSUB(b.x)], 1u);
        const unsigned gen = old / nloc;
        if (old + 1u == (gen + 1u) * nloc) {
            __builtin_amdgcn_fence(__ATOMIC_RELEASE, "agent");
            asm volatile("s_waitcnt vmcnt(0)" ::: "memory");
            const unsigned og = xb_add(&bar[XB_TOP], 1u);
            const unsigned tg = og / nx;
            if (og + 1u == (tg + 1u) * nx) xb_add(&bar[XB_TOPGEN], 1u);
            else XB_SPIN(xb_ld(&bar[XB_TOPGEN]) == tg, bar);
            __builtin_amdgcn_fence(__ATOMIC_ACQUIRE, "agent");
            xb_add(&bar[XB_XGEN(b.x)], 1u);
            asm volatile("s_waitcnt vmcnt(0)" ::: "memory");
        } else {
            XB_SPIN(xb_ld(&bar[XB_XGEN(b.x)]) == gen, bar);
            __builtin_amdgcn_fence(__ATOMIC_ACQUIRE, "agent");
            asm volatile("s_waitcnt vmcnt(0)" ::: "memory");
        }
    }
    __syncthreads();
}

__global__ void __launch_bounds__(512, 2) fwd(Args a) {
    extern __shared__ __attribute__((aligned(16))) unsigned char lds_raw[];
    LAS unsigned char* lds = (LAS unsigned char*)lds_raw;
    unsigned char* ws = a.ws;
    const int G = gridDim.x;
    bf16_t* WT = (bf16_t*)(ws + WS_WT);
#if MEGA
    cg::grid_group grid = cg::this_grid();
    unsigned* barw = (unsigned*)(ws + WS_BAR);
    volatile LAS unsigned* xst = (volatile LAS unsigned*)(lds + XBST_OFF);
    if (threadIdx.x < 4) xst[threadIdx.x] = 0u;
    __syncthreads();
    XcdBarrier xb = xcd_barrier_post(barw, xst);
    if (a.lo < 0) grid.sync();
#define SEAM0() xcd_barrier(xb)
#define SEAM() xcd_barrier(xb)
#else
#define SEAM0() do {} while (0)
#define SEAM() do {} while (0)
#endif
#define IN(k) (a.lo <= (k) && (k) < a.hi)
    if (IN(0)) phase0(a, lds);
    if (IN(0) && IN(1)) SEAM0();
    if (IN(1)) {
        Gemm g{(const bf16_t*)(ws + WS_R0), WT + (size_t)WROW1 * D_, M_, 4096, D_}; StaticOrder S; S.init(M_, 4096, G, (int)blockIdx.x);
        Epi1 E{(bf16_t*)(ws + WS_R1), a.conv_a, (float*)(ws + WS_VL), (float*)(ws + WS_G), (float*)(ws + WS_YP), (LAS float*)(lds + HALO_OFF)};
        gemm_phase<Epi1>(lds, g, S, E);
    }
    if (IN(1) && IN(2)) SEAM();
    if (IN(2)) {
        StaticOrder S; S.init(M_, 1024, G, (int)blockIdx.x);
        { Unit u; for (int i = 0; S.next(i, u); ++i) patch_y(a, u.pm); }
        { LAS float* it = (LAS float*)(lds + RSTD_OFF); const float* rs0 = (const float*)(ws + WS_RSTD0);
          Unit u; for (int i = 0; i < 8 && S.next(i, u); ++i) if (threadIdx.x < 256) it[i * 256 + threadIdx.x] = rs0[u.pm * BM + threadIdx.x];
          LAS float* ig = (LAS float*)(lds + ROPER_OFF);
          for (int i = threadIdx.x; i < D_; i += 512) ig[i] = 1.0f / a.ln_a[i]; }
        asm volatile("s_waitcnt vmcnt(0)" ::: "memory"); __syncthreads();
        Gemm g{(const bf16_t*)(ws + WS_R1), WT + (size_t)WROW2 * D_, M_, 1024, D_};
        Epi2 E{(bf16_t*)(ws + WS_R0), (float*)(ws + WS_SSQ), (const LAS float*)(lds + RSTD_OFF), (const LAS float*)(lds + ROPER_OFF)};
        gemm_phase<Epi2>(lds, g, S, E);
    }
    if (IN(2) && IN(3)) SEAM();
    if (IN(3)) {
        Gemm g{(const bf16_t*)(ws + WS_R0), WT + (size_t)WROW3 * D_, M_, 2560, D_}; StaticOrder S; S.init(M_, 2560, G, (int)blockIdx.x);
        { LAS float* rt = (LAS float*)(lds + RSTD_OFF); const float* SSQ = (const float*)(ws + WS_SSQ);
          Unit u; for (int i = 0; i < 8 && S.next(i, u); ++i)
              if (threadIdx.x < 256) { const f32x4* sp = (const f32x4*)(SSQ + (size_t)(u.pm * BM + threadIdx.x) * 16); const f32x4 s0 = sp[0], s1 = sp[1], s2 = sp[2], s3 = sp[3];
                  const float tot = ((s0[0] + s0[1]) + (s0[2] + s0[3])) + ((s1[0] + s1[1]) + (s1[2] + s1[3])) + ((s2[0] + s2[1]) + (s2[2] + s2[3])) + ((s3[0] + s3[1]) + (s3[2] + s3[3]));
                  rt[i * 256 + threadIdx.x] = rsqrtf(tot * (1.0f / 1024.0f) + EPS_); }
          const float* ropeG = (const float*)(ws + WS_ROPE);
          for (int i = threadIdx.x; i < 1024; i += 512) *(LAS f32x4*)(lds + ROPER_OFF + i * 16) = *(const f32x4*)(ropeG + i * 4);
          if (threadIdx.x < 128) ((LAS float*)(lds + GAIN_OFF))[threadIdx.x] = (threadIdx.x < 64) ? a.k_norm[threadIdx.x] : a.q_norm[threadIdx.x - 64];
          __syncthreads(); }
        Epi3 E{(const LAS float*)(lds + RSTD_OFF), (const LAS float*)(lds + ROPER_OFF), (const LAS float*)(lds + GAIN_OFF), (const float*)(ws + WS_ROPE) + 256 * 16, (bf16_t*)(ws + WS_KB), (bf16_t*)(ws + WS_VB), (bf16_t*)(ws + WS_R1), (bf16_t*)(ws + WS_ZB)};
        gemm_phase<Epi3>(lds, g, S, E);
    }
    if (IN(3) && IN(4)) SEAM();
    if (IN(4)) attn_phase(a, lds);
    if (IN(4) && IN(5)) SEAM();
    if (IN(5)) {
        Gemm g{(const bf16_t*)(ws + WS_OG), WT + (size_t)WROW4 * D_, M_, 1024, D_}; StaticOrder S; S.init(M_, 1024, G, (int)blockIdx.x);
        Epi4 E{(const bf16_t*)(ws + WS_R0), a.out};
        gemm_phase<Epi4>(lds, g, S, E);
    }
}

extern "C" void kernel_launch(void* const* d_in, const int* in_sizes, int n_in, void* d_out, int out_size, void* d_ws, size_t ws_size, hipStream_t stream) {
    static int grid = 0;
    if (grid == 0) {
        if (n_in != 13 || out_size != M_ * D_ || ws_size < WS_END) { fprintf(stderr, "kernel_launch: unexpected shapes (n_in %d out %d ws %zu)\n", n_in, out_size, ws_size); grid = -1; return; }
        int dev = 0, cus = 0, per_cu = 0;
        (void)hipGetDevice(&dev); (void)hipDeviceGetAttribute(&cus, hipDeviceAttributeMultiprocessorCount, dev);
        if (hipFuncSetAttribute((const void*)fwd, hipFuncAttributeMaxDynamicSharedMemorySize, LDS_BYTES) != hipSuccess) { fprintf(stderr, "kernel_launch: hipFuncSetAttribute failed\n"); grid = -1; return; }
        if (hipOccupancyMaxActiveBlocksPerMultiprocessor(&per_cu, (const void*)fwd, 512, LDS_BYTES) != hipSuccess || per_cu < 1) { fprintf(stderr, "kernel_launch: occupancy query failed (%d)\n", per_cu); (void)hipGetLastError(); per_cu = 1; }
        grid = cus * 1;
        (void)per_cu;
    }
    if (grid < 0) return;
    Args a{};
    a.x = (const float*)d_in[0]; a.ln_a = (const float*)d_in[1]; a.w_in_a = (const float*)d_in[2]; a.conv_a = (const float*)d_in[3]; a.w_out_a = (const float*)d_in[4];
    a.ln_kv = (const float*)d_in[5]; a.w_kv = (const float*)d_in[6]; a.k_norm = (const float*)d_in[7]; a.ln_b = (const float*)d_in[8]; a.w_in_b = (const float*)d_in[9];
    a.q_norm = (const float*)d_in[10]; a.sinks = (const float*)d_in[11]; a.w_out_b = (const float*)d_in[12];
    a.out = (float*)d_out; a.ws = (unsigned char*)d_ws + ((ws_size - WS_END) & ~(size_t)0xFFFFF);
    { float iv[8]; for (int i = 0; i < 8; ++i) iv[i] = (float)std::pow(500000.0, -(double)i / 8.0);
      a.inv0 = iv[0]; a.inv1 = iv[1]; a.inv2 = iv[2]; a.inv3 = iv[3]; a.inv4 = iv[4]; a.inv5 = iv[5]; a.inv6 = iv[6]; a.inv7 = iv[7]; }
#if MEGA
    a.lo = 0; a.hi = 6;
    if (hipMemsetAsync((char*)a.ws + WS_BAR, 0, XCD_BAR_WORDS * 4, stream) != hipSuccess) { fprintf(stderr, "kernel_launch: memset of barrier words failed\n"); return; }
    void* args[] = {&a};
    hipError_t e = hipLaunchCooperativeKernel((const void*)fwd, dim3(grid), dim3(512), args, LDS_BYTES, stream);
    if (e != hipSuccess) fprintf(stderr, "cooperative launch failed: %s (grid %d)\n", hipGetErrorString(e), grid);
#else
    for (int p = 0; p < 6; ++p) { a.lo = p; a.hi = p + 1; hipLaunchKernelGGL(fwd, dim3(grid), dim3(512), LDS_BYTES, stream, a); }
#endif
}
```

```cpp
#include <hip/hip_runtime.h>
#include <hip/hip_cooperative_groups.h>
#include <cstdio>
#include <cmath>
namespace cg = cooperative_groups;

#ifndef MEGA
#define MEGA 1
#endif

#define LAS __attribute__((address_space(3)))
typedef unsigned short bf16_t;
typedef short bf16x8 __attribute__((ext_vector_type(8)));
typedef float f32x4 __attribute__((ext_vector_type(4)));
typedef float f32x16 __attribute__((ext_vector_type(16)));
typedef unsigned u32x4 __attribute__((ext_vector_type(4)));
typedef unsigned u32x2 __attribute__((ext_vector_type(2)));

constexpr int M_ = 32768, D_ = 1024, SEQ_ = 8192;
constexpr float EPS_ = 1e-6f;
constexpr int BM = 256, BK = 64, HALF = 128, HTB = HALF * BK * 2, STAGE_BYTES = 8 * HTB, NXCD = 8, WGM = 8;
constexpr int HALO_OFF = STAGE_BYTES;
constexpr int RSTD_OFF = STAGE_BYTES + 2048;
constexpr int XBST_OFF = STAGE_BYTES + 2048 + 8192;
constexpr int ROPER_OFF = XBST_OFF + 64;
constexpr int GAIN_OFF = ROPER_OFF + 16384;
constexpr int LDS_BYTES = GAIN_OFF + 512;

constexpr size_t MB = 1024 * 1024;
constexpr size_t WS_R0 = 256 * MB;
constexpr size_t WS_R1 = 64 * MB;
constexpr size_t WS_ZB = 128 * MB;
constexpr size_t WS_KB = 192 * MB;
constexpr size_t WS_VB = 208 * MB;
constexpr size_t WS_WT = 224 * MB;
constexpr size_t WS_SSQ = 242 * MB;
constexpr size_t WS_ROPE = 245 * MB;
constexpr size_t WS_VL = 246 * MB;
constexpr size_t WS_G = 247 * MB;
constexpr size_t WS_YP = 248 * MB;
constexpr size_t WS_OG = WS_R1;
constexpr size_t WS_BAR = 320 * MB;
constexpr size_t WS_RSTD0 = 321 * MB;
constexpr size_t WS_END = 322 * MB;
constexpr int WROW1 = 0, WROW2 = 4096, WROW3 = 5120, WROW4 = 7680, WROWS = 8704;

struct Args {
    const float* x; const float* ln_a; const float* w_in_a; const float* conv_a; const float* w_out_a;
    const float* ln_kv; const float* w_kv; const float* k_norm; const float* ln_b; const float* w_in_b;
    const float* q_norm; const float* sinks; const float* w_out_b;
    float* out; unsigned char* ws;
    float inv0, inv1, inv2, inv3, inv4, inv5, inv6, inv7;
    int lo, hi;
};

typedef float f32x2_t __attribute__((ext_vector_type(2)));
typedef __bf16 bf16x2_t __attribute__((ext_vector_type(2)));
__device__ __forceinline__ unsigned cvt_pk_bf16(float lo, float hi) { const f32x2_t v = {lo, hi}; return __builtin_bit_cast(unsigned, __builtin_convertvector(v, bf16x2_t)); }
__device__ __forceinline__ bf16_t f2bf(float f) { unsigned u = __float_as_uint(f); u += 0x7FFFu + ((u >> 16) & 1u); return (bf16_t)(u >> 16); }
__device__ __forceinline__ float bf2f(unsigned short b) { return __uint_as_float(((unsigned)b) << 16); }
__device__ __forceinline__ float silu_f(float z) { return z * __builtin_amdgcn_rcpf(1.0f + __expf(-z)); }

__host__ __device__ __forceinline__ int lds_byte(int r, int c) { const int st = (r >> 4) * 2 + (c >> 5), rr = r & 15, cc = c & 31, ob = rr * 64 + cc * 2; return st * 1024 + (ob ^ (((ob >> 9) & 1) << 5)); }
__host__ __device__ __forceinline__ void stage_rc(int b, int& R, int& C) { const int st = b / 1024, sb = b % 1024, swz = sb ^ (((sb >> 9) & 1) << 5); R = (st >> 1) * 16 + swz / 64; C = (st & 1) * 32 + (swz % 64) / 2; }

__host__ __device__ __forceinline__ int perm32(int rho) { const int n = rho >> 4, i = rho & 15; return 8 * (i >> 2) + 4 * n + (i & 3); }
struct Unit { int pm, pn; };
struct Gemm { const bf16_t* A; const bf16_t* Bt; int M, N, K; };
struct StaticOrder {
    int nM, nN, nwg, G, c;
    __device__ void init(int M, int N, int G_, int c_) { nM = M / BM; nN = N / BM; nwg = nM * nN; G = G_; c = c_; }
    __device__ bool next(int i, Unit& u) const {
        const long L = (long)i * G + c; if (L >= nwg) return false;
        int wgid = (int)L; { const int q = nwg / NXCD, r = nwg % NXCD, xcd = wgid % NXCD, off = wgid / NXCD; wgid = (xcd < r ? xcd * (q + 1) : r * (q + 1) + (xcd - r) * q) + off; }
        const int nig = WGM * nN, gid = wgid / nig, fm = gid * WGM, gsz = (nM - fm) < WGM ? (nM - fm) : WGM;
        u.pm = fm + ((wgid % nig) % gsz); u.pn = (wgid % nig) / gsz; return true;
    }
};

template <class Epi>
__device__ __forceinline__ void gemm_phase(LAS unsigned char* lds, const Gemm g, const StaticOrder& S, const Epi& E) {
    const int tid = threadIdx.x, wid = __builtin_amdgcn_readfirstlane(tid >> 6), lane = tid & 63, wr = wid >> 2, wc = wid & 3, fr = lane & 15, fq = lane >> 4;
    const int K = g.K, nt = K / BK;
    unsigned voffA[2], voffB[2];
#pragma unroll
    for (int i = 0; i < 2; ++i) { int R, C; stage_rc(tid * 16 + i * 8192, R, C); const int Rb = Epi::PERM ? ((R & ~31) + perm32(R & 31)) : R;
        const int Ra = Epi::AMAP ? (128 * (R >> 6) + (R & 63)) : R;
        voffA[i] = (unsigned)(Ra * K + C) * 2u; voffB[i] = (unsigned)(Rb * K + C) * 2u; }
    const size_t kstep = (size_t)(BK * 2);
    const size_t hstep = (size_t)HALF * K * 2;
    const size_t hstepA = Epi::AMAP ? (size_t)64 * K * 2 : hstep;
    const size_t tstep = 2 * hstep;
    const unsigned ldsw = (unsigned)wid * 1024u;
    const int aoff = lds_byte(wr * 64 + fr, fq * 8), boff = lds_byte(wc * 32 + fr, fq * 8);
#define PG8_SA(b, h) (((b) * 2 + (h)) * HTB)
#define PG8_SB(b, h) ((4 + (b) * 2 + (h)) * HTB)
#define PG8_STAGE(bufoff, gbase, voff) do { _Pragma("unroll") for (int _i = 0; _i < 2; ++_i) \
        __builtin_amdgcn_global_load_lds((const unsigned*)((const char*)(gbase) + (voff)[_i]), (LAS unsigned*)(lds + (bufoff) + ldsw + _i * 8192), 16, 0, 0); } while (0)
#define PG8_LDA(dst, b, h) do { _Pragma("unroll") for (int m = 0; m < 4; ++m) _Pragma("unroll") for (int k = 0; k < 2; ++k) dst[m][k] = *(const LAS bf16x8*)(lds + PG8_SA(b, h) + aoff + m * 2048 + k * 1024); } while (0)
#define PG8_LDB(dst, b, h) do { _Pragma("unroll") for (int n = 0; n < 2; ++n) _Pragma("unroll") for (int k = 0; k < 2; ++k) dst[n][k] = *(const LAS bf16x8*)(lds + PG8_SB(b, h) + boff + n * 2048 + k * 1024); } while (0)
#define PG8_MMA(ai, bj, At, Bt) do { __builtin_amdgcn_s_setprio(1); _Pragma("unroll") for (int m = 0; m < 4; ++m) _Pragma("unroll") for (int n = 0; n < 2; ++n) _Pragma("unroll") for (int k = 0; k < 2; ++k) \
        acc[ai][bj][m][n] = __builtin_amdgcn_mfma_f32_16x16x32_bf16(Bt[n][k], At[m][k], acc[ai][bj][m][n], 0, 0, 0); __builtin_amdgcn_s_setprio(0); } while (0)
#define PG8_WAIT_V(n) asm volatile("s_waitcnt vmcnt(" #n ")" ::: "memory")
#define PG8_WAIT_L(n) asm volatile("s_waitcnt lgkmcnt(" #n ")" ::: "memory")
#define PG8_BAR __builtin_amdgcn_s_barrier()
#define PG8_SCHED __builtin_amdgcn_sched_barrier(0)
    Unit cur, nxt; int ui = 0;
    if (!S.next(0, cur)) return;
    f32x4 acc[2][2][4][2];
#pragma unroll
    for (int a = 0; a < 2; ++a)
#pragma unroll
        for (int b = 0; b < 2; ++b)
#pragma unroll
            for (int m = 0; m < 4; ++m)
#pragma unroll
                for (int n = 0; n < 2; ++n) acc[a][b][m][n] = (f32x4){0.f, 0.f, 0.f, 0.f};
    bf16x8 At[4][2], B0[2][2], B1[2][2];
    const char* cA = (const char*)g.A + (size_t)cur.pm * tstep; const char* cB = (const char*)g.Bt + (size_t)cur.pn * tstep;
    PG8_STAGE(PG8_SB(0, 0), cB, voffB); PG8_STAGE(PG8_SB(0, 1), cB + hstep, voffB); PG8_STAGE(PG8_SA(0, 0), cA, voffA); PG8_STAGE(PG8_SA(0, 1), cA + hstepA, voffA);
    if (wr == 1) PG8_BAR;
    PG8_WAIT_V(2); PG8_BAR;
    PG8_STAGE(PG8_SB(1, 0), cB + kstep, voffB); PG8_STAGE(PG8_SA(1, 0), cA + kstep, voffA); PG8_STAGE(PG8_SB(1, 1), cB + hstep + kstep, voffB);
    PG8_WAIT_V(6); PG8_BAR;
    for (;;) {
        const bool has_next = S.next(ui + 1, nxt);
        const char* nA = has_next ? (const char*)g.A + (size_t)nxt.pm * tstep : cA; const char* nB = has_next ? (const char*)g.Bt + (size_t)nxt.pn * tstep : cB;
        for (int t = 0; t < nt; t += 2) {
            const bool last = (t == nt - 2);
            const char* a1 = cA + (size_t)(t + 1) * kstep;
            const char* a2 = last ? nA : cA + (size_t)(t + 2) * kstep; const char* b2 = last ? nB : cB + (size_t)(t + 2) * kstep;
            const char* a3 = a2 + kstep; const char* b3 = b2 + kstep;
            PG8_LDB(B0, 0, 0); PG8_LDB(B1, 0, 1); PG8_SCHED; PG8_LDA(At, 0, 0); PG8_STAGE(PG8_SA(1, 1), a1 + hstepA, voffA);
            PG8_WAIT_V(8); PG8_WAIT_L(0); PG8_BAR; PG8_MMA(0, 0, At, B0); PG8_MMA(0, 1, At, B1); PG8_BAR; PG8_SCHED;
            PG8_LDA(At, 0, 1); PG8_STAGE(PG8_SB(0, 0), b2, voffB); PG8_STAGE(PG8_SB(0, 1), b2 + hstep, voffB); PG8_STAGE(PG8_SA(0, 0), a2, voffA);
            PG8_WAIT_V(8); PG8_WAIT_L(0); PG8_BAR; PG8_MMA(1, 0, At, B0); PG8_MMA(1, 1, At, B1); PG8_BAR; PG8_SCHED;
            PG8_LDB(B0, 1, 0); PG8_LDB(B1, 1, 1); PG8_SCHED; PG8_LDA(At, 1, 0); PG8_STAGE(PG8_SA(0, 1), a2 + hstepA, voffA);
            PG8_WAIT_V(8); PG8_WAIT_L(0); PG8_BAR; PG8_MMA(0, 0, At, B0); PG8_MMA(0, 1, At, B1); PG8_BAR; PG8_SCHED;
            PG8_LDA(At, 1, 1); PG8_STAGE(PG8_SB(1, 0), b3, voffB); PG8_STAGE(PG8_SB(1, 1), b3 + hstep, voffB); PG8_STAGE(PG8_SA(1, 0), a3, voffA);
            PG8_WAIT_V(8); PG8_WAIT_L(0); PG8_BAR; PG8_MMA(1, 0, At, B0); PG8_MMA(1, 1, At, B1); PG8_BAR; PG8_SCHED;
        }
        if (wr == 0) PG8_BAR;
        E(acc, cur, ui, wr, wc, fr, fq);
        if (!has_next) break;
#pragma unroll
        for (int a = 0; a < 2; ++a)
#pragma unroll
            for (int b = 0; b < 2; ++b)
#pragma unroll
                for (int m = 0; m < 4; ++m)
#pragma unroll
                    for (int n = 0; n < 2; ++n) acc[a][b][m][n] = (f32x4){0.f, 0.f, 0.f, 0.f};
        cur = nxt; cA = nA; cB = nB; ++ui;
        if (wr == 1) PG8_BAR;
    }
    PG8_WAIT_V(0);
    PG8_BAR;
#undef PG8_SA
#undef PG8_SB
#undef PG8_STAGE
#undef PG8_LDA
#undef PG8_LDB
#undef PG8_MMA
#undef PG8_WAIT_V
#undef PG8_WAIT_L
#undef PG8_BAR
#undef PG8_SCHED
}

__device__ __forceinline__ void st_bf16x4(bf16_t* p, const f32x4 v) { u32x2 w; w.x = cvt_pk_bf16(v[0], v[1]); w.y = cvt_pk_bf16(v[2], v[3]); *(u32x2*)p = w; }

__device__ __forceinline__ float dpp_ror1(float v) { return __builtin_bit_cast(float, __builtin_amdgcn_update_dpp(0, __builtin_bit_cast(int, v), 0x121, 0xf, 0xf, false)); }
__device__ __forceinline__ float dpp_ror2(float v) { return __builtin_bit_cast(float, __builtin_amdgcn_update_dpp(0, __builtin_bit_cast(int, v), 0x122, 0xf, 0xf, false)); }
struct Epi1 {
    static constexpr bool PERM = false, AMAP = true;
    bf16_t* Y; const LAS float* convw; float* VL; float* G; float* YP; LAS float* hal;
    __device__ __forceinline__ void operator()(f32x4 (&acc)[2][2][4][2], const Unit& u, int ui, int wr, int wc, int fr, int fq) const {
        const int ch = u.pn * 64 + wc * 16 + 8 * (fq & 1) + 4 * (fq >> 1);
        const f32x4 w0 = *(const LAS f32x4*)(convw + ch), w1 = *(const LAS f32x4*)(convw + 1024 + ch), w2 = *(const LAS f32x4*)(convw + 2048 + ch);
#pragma unroll
        for (int ai = 0; ai < 2; ++ai)
#pragma unroll
            for (int m = 0; m < 4; ++m) {
                const f32x4 Bv = acc[ai][0][m][0], Cv = acc[ai][0][m][1], Uv = acc[ai][1][m][0], Zv = acc[ai][1][m][1];
                f32x4 gt, v;
#pragma unroll
                for (int j = 0; j < 4; ++j) { gt[j] = Bv[j] * silu_f(Zv[j]); v[j] = Cv[j] * Uv[j]; }
                acc[ai][0][m][0] = gt; acc[ai][0][m][1] = v;
            }
        LAS float* hp = hal + (fr & 1) * 64 + wc * 16 + fq * 4;
        f32x4 vprev = (f32x4){0.f, 0.f, 0.f, 0.f};
        if (wr == 0 && fr >= 14) *(LAS f32x4*)hp = acc[1][0][3][1];
        asm volatile("s_waitcnt lgkmcnt(0)" ::: "memory"); __builtin_amdgcn_s_barrier(); asm volatile("" ::: "memory");
        if (wr == 1 && fr >= 14) vprev = *(const LAS f32x4*)hp;
#pragma unroll
        for (int ai = 0; ai < 2; ++ai)
#pragma unroll
            for (int mp = 0; mp < 2; ++mp) {
                unsigned yp[2][2];
#pragma unroll
                for (int mm = 0; mm < 2; ++mm) {
                    const int m = 2 * mp + mm;
                    const f32x4 vc = acc[ai][0][m][1], gt = acc[ai][0][m][0];
                    f32x4 y;
#pragma unroll
                    for (int j = 0; j < 4; ++j) {
                        const float c1 = (fr == 15) ? vprev[j] : vc[j], c2 = (fr >= 14) ? vprev[j] : vc[j];
                        const float vm1 = dpp_ror1(c1), vm2 = dpp_ror2(c2);
                        y[j] = gt[j] * (w0[j] * vm2 + w1[j] * vm1 + w2[j] * vc[j]);
                    }
                    yp[mm][0] = cvt_pk_bf16(y[0], y[1]); yp[mm][1] = cvt_pk_bf16(y[2], y[3]);
                    if (wr == 0 && ai == 0 && m == 0 && fr < 2) { *(f32x4*)(G + (size_t)(u.pm * 2 + fr) * D_ + ch) = gt; *(f32x4*)(YP + (size_t)(u.pm * 2 + fr) * D_ + ch) = y; }
                    if (wr == 1 && ai == 1 && m == 3 && fr >= 14) *(f32x4*)(VL + (size_t)(u.pm * 2 + fr - 14) * D_ + ch) = vc;
                    vprev = vc;
                }
                { auto r0 = __builtin_amdgcn_permlane32_swap(yp[0][0], yp[1][0], false, false); auto r1 = __builtin_amdgcn_permlane32_swap(yp[0][1], yp[1][1], false, false);
                  const int row = u.pm * BM + wr * HALF + ai * 64 + (2 * mp + (fq >> 1)) * 16 + fr;
                  *(u32x4*)(Y + (size_t)row * D_ + u.pn * 64 + wc * 16 + 8 * (fq & 1)) = (u32x4){r0[0], r1[0], r0[1], r1[1]}; }
            }
    }
};
__device__ __forceinline__ void st_bf16x8(bf16_t* p, const f32x4 v0, const f32x4 v1) { u32x4 w; w.x = cvt_pk_bf16(v0[0], v0[1]); w.y = cvt_pk_bf16(v0[2], v0[3]); w.z = cvt_pk_bf16(v1[0], v1[1]); w.w = cvt_pk_bf16(v1[2], v1[3]); *(u32x4*)p = w; }
struct Epi2 {
    static constexpr bool PERM = true, AMAP = false;
    bf16_t* HX; float* SSQ; const LAS float* irs_tab; const LAS float* invg;
    __device__ __forceinline__ void operator()(f32x4 (&acc)[2][2][4][2], const Unit& u, int ui, int wr, int wc, int fr, int fq) const {
        const int rl0 = wr * 64 + fr, row0 = u.pm * BM + rl0, col0 = u.pn * BM + wc * 32 + 8 * fq;
        f32x4 ig[2][2];
#pragma unroll
        for (int bj = 0; bj < 2; ++bj)
#pragma unroll
            for (int n = 0; n < 2; ++n) ig[bj][n] = *(const LAS f32x4*)(invg + col0 + bj * HALF + 4 * n);
        {
            u32x4 hb[16];
#define EPI2_LOAD(k) hb[k] = *(const u32x4*)(HX + (size_t)(row0 + ((k) >> 3) * HALF + (((k) >> 1) & 3) * 16) * D_ + col0 + ((k) & 1) * HALF)
#pragma unroll
            for (int k = 0; k < 8; ++k) EPI2_LOAD(k);
#pragma unroll
            for (int k = 0; k < 16; ++k) {
                if (k + 8 < 16) EPI2_LOAD(k + 8);
                const int ai = k >> 3, m = (k >> 1) & 3, bj = k & 1;
                const float irs = irs_tab[ui * 256 + rl0 + ai * HALF + m * 16];
                const u32x4 w = hb[k];
                const f32x4 h0 = (f32x4){__uint_as_float(w.x << 16), __uint_as_float(w.x & 0xffff0000u), __uint_as_float(w.y << 16), __uint_as_float(w.y & 0xffff0000u)};
                const f32x4 h1 = (f32x4){__uint_as_float(w.z << 16), __uint_as_float(w.z & 0xffff0000u), __uint_as_float(w.w << 16), __uint_as_float(w.w & 0xffff0000u)};
                acc[ai][bj][m][0] += h0 * ig[bj][0] * irs; acc[ai][bj][m][1] += h1 * ig[bj][1] * irs;
                asm volatile("" : "+v"(acc[ai][bj][m][0]), "+v"(acc[ai][bj][m][1]));
                __builtin_amdgcn_sched_barrier(0);
            }
#undef EPI2_LOAD
            asm volatile("" ::: "memory"); __builtin_amdgcn_sched_barrier(0);
        }
#pragma unroll
        for (int ai = 0; ai < 2; ++ai)
#pragma unroll
            for (int m = 0; m < 4; ++m) {
                const int row = row0 + ai * HALF + m * 16; float ss = 0.f;
#pragma unroll
                for (int bj = 0; bj < 2; ++bj) {
                    const f32x4 o0 = acc[ai][bj][m][0], o1 = acc[ai][bj][m][1];
                    st_bf16x8(HX + (size_t)row * D_ + col0 + bj * HALF, o0, o1);
                    ss += ((o0[0] * o0[0] + o0[1] * o0[1]) + (o0[2] * o0[2] + o0[3] * o0[3])) + ((o1[0] * o1[0] + o1[1] * o1[1]) + (o1[2] * o1[2] + o1[3] * o1[3]));
                }
                ss += __shfl_xor(ss, 16); ss += __shfl_xor(ss, 32);
                if (fq == 0) SSQ[(size_t)row * 16 + u.pn * 4 + wc] = ss;
            }
    }
};
struct Epi3 {
    static constexpr bool PERM = true, AMAP = false;
    const LAS float* rstd_tab; const LAS float* ropeR; const LAS float* gains; const float* ropeB; bf16_t* KB; bf16_t* VB; bf16_t* QB; bf16_t* ZB;
    __device__ __forceinline__ void operator()(f32x4 (&acc)[2][2][4][2], const Unit& u, int ui, int wr, int wc, int fr, int fq) const {
        const int pn = u.pn;
        const bool isk = (pn == 0), isq = (pn >= 2 && pn < 6);
        const int rl0 = wr * 64 + fr;
        if (isk || isq) {
            const LAS float* gp = gains + (isk ? 0 : 64);
            f32x4 gn[2][2];
#pragma unroll
            for (int bj = 0; bj < 2; ++bj)
#pragma unroll
                for (int n = 0; n < 2; ++n) gn[bj][n] = *(const LAS f32x4*)(gp + 32 * bj + 8 * fq + 4 * n);
            const float* rb = ropeB + (u.pm & 31) * 16;
            f32x4 cB[2], sB[2];
#pragma unroll
            for (int n = 0; n < 2; ++n) { cB[n] = *(const f32x4*)(rb + 4 * n); sB[n] = *(const f32x4*)(rb + 8 + 4 * n); }
            bf16_t* dst0; int ld;
            if (isk) { dst0 = KB + wc * 64; ld = 256; } else { dst0 = QB + (pn - 2) * 256 + wc * 64; ld = D_; }
#pragma unroll
            for (int ai = 0; ai < 2; ++ai)
#pragma unroll
                for (int m = 0; m < 4; ++m) {
                    const int rl = rl0 + ai * HALF + m * 16;
                    const float rstd = rstd_tab[ui * 256 + rl];
                    f32x4 v[2][2]; float ss = 0.f;
#pragma unroll
                    for (int bj = 0; bj < 2; ++bj)
#pragma unroll
                        for (int n = 0; n < 2; ++n) { v[bj][n] = acc[ai][bj][m][n] * rstd; ss += (v[bj][n][0] * v[bj][n][0] + v[bj][n][1] * v[bj][n][1]) + (v[bj][n][2] * v[bj][n][2] + v[bj][n][3] * v[bj][n][3]); }
                    ss += __shfl_xor(ss, 16); ss += __shfl_xor(ss, 32);
                    float rs = rsqrtf(ss * (1.0f / 64.0f) + EPS_);
                    if (isq) rs *= 0.18033688011112042f;
#pragma unroll
                    for (int bj = 0; bj < 2; ++bj)
#pragma unroll
                        for (int n = 0; n < 2; ++n) v[bj][n] = v[bj][n] * rs * gn[bj][n];
#pragma unroll
                    for (int n = 0; n < 2; ++n) {
                        const f32x4 cA = *(const LAS f32x4*)(ropeR + rl * 16 + 4 * n), sA = *(const LAS f32x4*)(ropeR + rl * 16 + 8 + 4 * n);
                        const f32x4 cs = cA * cB[n] - sA * sB[n], sn = sA * cB[n] + cA * sB[n];
#pragma unroll
                        for (int j = 0; j < 4; ++j) {
                            const float me = v[0][n][j], pr = __shfl_xor(me, 16);
                            const float ro = (fq == 0) ? (me * cs[j] - pr * sn[j]) : (me * cs[j] + pr * sn[j]);
                            v[0][n][j] = (fq < 2) ? ro : me;
                        }
                    }
                    bf16_t* dst = dst0 + (size_t)(u.pm * BM + rl) * ld + 8 * fq;
#pragma unroll
                    for (int bj = 0; bj < 2; ++bj) st_bf16x8(dst + 32 * bj, v[bj][0], v[bj][1]);
                }
        } else {
            bf16_t* dst0; int ld;
            if (pn == 1) { dst0 = VB + wc * 64; ld = 256; } else { dst0 = ZB + (pn - 6) * 256 + wc * 64; ld = D_; }
            const bool act = (pn != 1);
#pragma unroll
            for (int ai = 0; ai < 2; ++ai)
#pragma unroll
                for (int m = 0; m < 4; ++m) {
                    const float rstd = rstd_tab[ui * 256 + rl0 + ai * HALF + m * 16];
                    bf16_t* dst = dst0 + (size_t)(u.pm * BM + rl0 + ai * HALF + m * 16) * ld + 8 * fq;
#pragma unroll
                    for (int bj = 0; bj < 2; ++bj) {
                        f32x4 v0 = acc[ai][bj][m][0] * rstd, v1 = acc[ai][bj][m][1] * rstd;
                        if (act) {
#pragma unroll
                            for (int j = 0; j < 4; ++j) { v0[j] = silu_f(v0[j]); v1[j] = silu_f(v1[j]); }
                        }
                        st_bf16x8(dst + 32 * bj, v0, v1);
                    }
                }
        }
    }
};
struct Epi4 {
    static constexpr bool PERM = true, AMAP = false;
    const bf16_t* X1B; float* O;
    __device__ __forceinline__ void operator()(f32x4 (&acc)[2][2][4][2], const Unit& u, int ui, int wr, int wc, int fr, int fq) const {
        const int row0 = u.pm * BM + wr * 64 + fr, col0 = u.pn * BM + wc * 32 + 8 * fq;
        {
            u32x4 xb[2][4][2];
#pragma unroll
            for (int ai = 0; ai < 2; ++ai)
#pragma unroll
                for (int m = 0; m < 4; ++m)
#pragma unroll
                    for (int bj = 0; bj < 2; ++bj) xb[ai][m][bj] = *(const u32x4*)(X1B + (size_t)(row0 + ai * HALF + m * 16) * D_ + col0 + bj * HALF);
#pragma unroll
            for (int ai = 0; ai < 2; ++ai)
#pragma unroll
                for (int m = 0; m < 4; ++m)
#pragma unroll
                    for (int bj = 0; bj < 2; ++bj) {
                        const u32x4 w = xb[ai][m][bj];
                        acc[ai][bj][m][0] += (f32x4){__uint_as_float(w.x << 16), __uint_as_float(w.x & 0xffff0000u), __uint_as_float(w.y << 16), __uint_as_float(w.y & 0xffff0000u)};
                        acc[ai][bj][m][1] += (f32x4){__uint_as_float(w.z << 16), __uint_as_float(w.z & 0xffff0000u), __uint_as_float(w.w << 16), __uint_as_float(w.w & 0xffff0000u)};
                        asm volatile("" : "+v"(acc[ai][bj][m][0]), "+v"(acc[ai][bj][m][1]));
                    }
            asm volatile("" ::: "memory"); __builtin_amdgcn_sched_barrier(0);
        }
#pragma unroll
        for (int ai = 0; ai < 2; ++ai)
#pragma unroll
            for (int m = 0; m < 4; ++m)
#pragma unroll
                for (int bj = 0; bj < 2; ++bj) {
                    float* p = O + (size_t)(row0 + ai * HALF + m * 16) * D_ + col0 + bj * HALF;
                    *(f32x4*)p = acc[ai][bj][m][0]; *(f32x4*)(p + 4) = acc[ai][bj][m][1];
                }
    }
};

__device__ __forceinline__ void sincos_d(double a, float& c, float& s) {
    const double q = rint(a * 0.63661977236758134308);
    double r = fma(-q, 1.57079632679489655800, a); r = fma(-q, 6.12323399573676603587e-17, r);
    const double r2 = r * r;
    double sp = -7.6471637318198164759e-13; sp = fma(sp, r2, 1.6059043836821614599e-10); sp = fma(sp, r2, -2.5052108385441718775e-8); sp = fma(sp, r2, 2.7557319223985890653e-6);
    sp = fma(sp, r2, -1.9841269841269841270e-4); sp = fma(sp, r2, 8.3333333333333333333e-3); sp = fma(sp, r2, -1.6666666666666666667e-1);
    const double sr = fma(r * r2, sp, r);
    double cp = 4.7794773323873852974e-14; cp = fma(cp, r2, -1.1470745597729724714e-11); cp = fma(cp, r2, 2.0876756987868098979e-9); cp = fma(cp, r2, -2.7557319223985890653e-7);
    cp = fma(cp, r2, 2.4801587301587301587e-5); cp = fma(cp, r2, -1.3888888888888888889e-3); cp = fma(cp, r2, 4.1666666666666666667e-2); cp = fma(cp, r2, -0.5);
    const double cr = fma(r2, cp, 1.0);
    const int qi = ((int)q) & 3;
    const double sv = (qi == 0) ? sr : (qi == 1) ? cr : (qi == 2) ? -sr : -cr;
    const double cv = (qi == 0) ? cr : (qi == 1) ? -sr : (qi == 2) ? -cr : sr;
    c = (float)cv; s = (float)sv;
}

__device__ __forceinline__ void phase0(const Args& a, LAS unsigned char* lds) {
    const int tid = threadIdx.x, G = gridDim.x, wid = tid >> 6, lane = tid & 63;
    const int gw = blockIdx.x * 8 + wid, NW = G * 8;
    unsigned char* ws = a.ws;
    { float* rope = (float*)(ws + WS_ROPE);
      for (int e = blockIdx.x * 512 + tid; e < 288 * 8; e += G * 512) {
          const int q = e >> 3, i = e & 7; const float iv = (i == 0) ? a.inv0 : (i == 1) ? a.inv1 : (i == 2) ? a.inv2 : (i == 3) ? a.inv3 : (i == 4) ? a.inv4 : (i == 5) ? a.inv5 : (i == 6) ? a.inv6 : a.inv7;
          const int pos = (q < 256) ? q : (q - 256) * 256; float c, s; sincos_d((double)pos * (double)iv, c, s);
          rope[q * 16 + i] = c; rope[q * 16 + 8 + i] = s; } }
    { bf16_t* WT = (bf16_t*)(ws + WS_WT);
      LAS unsigned char* tile = lds + wid * 8448;
      for (int t = gw; t < (WROWS / 64) * 16; t += NW) {
          const int n0 = (t >> 4) * 64, k0 = (t & 15) * 64;
          const int np = n0 + lane;
          const float* W; int ld, col; const float* gain = nullptr;
          if (np < WROW2) { const int pn = np >> 8, ct = np & 255, bj = ct >> 7, wc = (ct >> 5) & 3, n = (ct >> 4) & 1, cc = ct & 15; W = a.w_in_a; ld = 4096; col = (2 * bj + n) * 1024 + 64 * pn + 16 * wc + (8 * ((cc >> 2) & 1) + 4 * (cc >> 3) + (cc & 3)); }
          else if (np < WROW3) { W = a.w_out_a; ld = 1024; col = np - WROW2; }
          else if (np < WROW4) { const int n3 = np - WROW3, pn = n3 >> 8, ct = n3 & 255, bj = ct >> 7, wc = (ct >> 5) & 3, cc = ct & 31; const int oc = 256 * pn + 64 * wc + 32 * bj + cc;
              if (oc < 512) { W = a.w_kv; ld = 512; col = oc; gain = a.ln_kv; } else { W = a.w_in_b; ld = 2048; col = oc - 512; gain = a.ln_b; } }
          else { W = a.w_out_b; ld = 1024; col = np - WROW4; }
          const float* src = W + (size_t)k0 * ld + col;
#pragma unroll
          for (int kb = 0; kb < 64; kb += 16) {
              float v[16];
#pragma unroll
              for (int i = 0; i < 16; ++i) v[i] = __builtin_nontemporal_load(src + (size_t)(kb + i) * ld);
              if (gain) {
#pragma unroll
                  for (int i = 0; i < 16; ++i) v[i] *= gain[k0 + kb + i];
              }
#pragma unroll
              for (int i = 0; i < 8; ++i) *(LAS unsigned*)(tile + lane * 132 + (kb + 2 * i) * 2) = cvt_pk_bf16(v[2 * i], v[2 * i + 1]);
          }
          asm volatile("s_waitcnt lgkmcnt(0)" ::: "memory");
#pragma unroll
          for (int it = 0; it < 8; ++it) {
              const int nl = it * 8 + (lane >> 3), k8 = (lane & 7) * 8;
              const LAS unsigned* rp = (const LAS unsigned*)(tile + nl * 132 + k8 * 2);
              u32x4 o; o.x = rp[0]; o.y = rp[1]; o.z = rp[2]; o.w = rp[3];
              *(u32x4*)(WT + (size_t)(n0 + nl) * D_ + k0 + k8) = o;
          }
          asm volatile("s_waitcnt lgkmcnt(0)" ::: "memory");
      } }
    { bf16_t* HB = (bf16_t*)(ws + WS_R0);
      f32x4 gv[4];
#pragma unroll
      for (int i = 0; i < 4; ++i) gv[i] = *(const f32x4*)(a.ln_a + i * 256 + lane * 4);
      for (int row = gw * 2; row < M_; row += NW * 2) {
          f32x4 xv[2][4];
#pragma unroll
          for (int rr = 0; rr < 2; ++rr)
#pragma unroll
              for (int i = 0; i < 4; ++i) xv[rr][i] = __builtin_nontemporal_load((const f32x4*)(a.x + (size_t)(row + rr) * D_ + i * 256 + lane * 4));
#pragma unroll
          for (int rr = 0; rr < 2; ++rr) {
              float ss = 0.f;
#pragma unroll
              for (int i = 0; i < 4; ++i) ss += (xv[rr][i][0] * xv[rr][i][0] + xv[rr][i][1] * xv[rr][i][1]) + (xv[rr][i][2] * xv[rr][i][2] + xv[rr][i][3] * xv[rr][i][3]);
#pragma unroll
              for (int o = 32; o >= 1; o >>= 1) ss += __shfl_xor(ss, o);
              const float ms = ss * (1.0f / 1024.0f) + EPS_;
              const float rstd = rsqrtf(ms);
              if (lane == 0) ((float*)(ws + WS_RSTD0))[row + rr] = sqrtf(ms);
#pragma unroll
              for (int i = 0; i < 4; ++i) st_bf16x4(HB + (size_t)(row + rr) * D_ + i * 256 + lane * 4, xv[rr][i] * rstd * gv[i]);
          }
      } }
    __syncthreads();
}

__device__ __forceinline__ void patch_y(const Args& a, int pm) {
    if ((pm & 31) == 0) return;
    unsigned char* ws = a.ws; const int tid = threadIdx.x, r = tid >> 8, c4 = (tid & 255) * 4;
    const float* VL = (const float*)(ws + WS_VL); const float* Gp = (const float*)(ws + WS_G); const float* YP = (const float*)(ws + WS_YP);
    const f32x4 yp = *(const f32x4*)(YP + (size_t)(pm * 2 + r) * D_ + c4), gt = *(const f32x4*)(Gp + (size_t)(pm * 2 + r) * D_ + c4);
    const f32x4 vl0 = *(const f32x4*)(VL + (size_t)((pm - 1) * 2 + 0) * D_ + c4), vl1 = *(const f32x4*)(VL + (size_t)((pm - 1) * 2 + 1) * D_ + c4);
    const f32x4 w0 = *(const f32x4*)(a.conv_a + c4), w1 = *(const f32x4*)(a.conv_a + 1024 + c4);
    const f32x4 add = (r == 0) ? (w0 * vl0 + w1 * vl1) : (w0 * vl1);
    st_bf16x4((bf16_t*)(ws + WS_R1) + (size_t)(pm * BM + r) * D_ + c4, yp + gt * add);
}

constexpr int KS_STRIDE = 144, VT_OFF = 256 * KS_STRIDE, VT_STRIDE = 528, ATT_BUF = VT_OFF + 64 * VT_STRIDE;
static_assert(2 * ATT_BUF <= XBST_OFF, "attention double buffer must stay below the barrier's LDS words");
__device__ __forceinline__ void attn_load_k(const bf16_t* KB, int it, int tid, u32x4 (&kr)[4]) {
    const int kvh = it & 3, blk = (it >> 2) & 63, b = it >> 8, t0 = b * SEQ_ + blk * 128;
    const bf16_t* p = KB + (size_t)(t0 - 128) * 256 + kvh * 64 + (tid >> 3) * 256 + (tid & 7) * 8;
#pragma unroll
    for (int i = 0; i < 4; ++i) { kr[i] = (u32x4){0u, 0u, 0u, 0u}; if (blk > 0 || i >= 2) kr[i] = *(const u32x4*)(p + i * 64 * 256); }
}
__device__ __forceinline__ void attn_load_v(const bf16_t* VB, int it, int tid, u32x4 (&vr)[4]) {
    const int kvh = it & 3, blk = (it >> 2) & 63, b = it >> 8, t0 = b * SEQ_ + blk * 128;
    const bf16_t* p = VB + (size_t)(t0 - 128) * 256 + kvh * 64 + (tid >> 3) * 512 + (tid & 7) * 8;
#pragma unroll
    for (int i = 0; i < 2; ++i)
#pragma unroll
        for (int kk = 0; kk < 2; ++kk) { vr[i * 2 + kk] = (u32x4){0u, 0u, 0u, 0u}; if (blk > 0 || i >= 1) vr[i * 2 + kk] = *(const u32x4*)(p + i * 128 * 256 + kk * 256); }
}
__device__ __forceinline__ void attn_store_k(LAS unsigned char* buf, int tid, const u32x4 (&kr)[4]) {
    LAS unsigned char* p = buf + (tid >> 3) * KS_STRIDE + (tid & 7) * 16;
#pragma unroll
    for (int i = 0; i < 4; ++i) *(LAS u32x4*)(p + i * 64 * KS_STRIDE) = kr[i];
}
__device__ __forceinline__ void attn_store_v(LAS unsigned char* buf, int tid, const u32x4 (&vr)[4]) {
    const int key0 = 2 * (tid >> 3), k16 = key0 & 15;
    const int pos = (key0 & ~15) | (8 * ((k16 >> 2) & 1) + 4 * (k16 >> 3) + (k16 & 3));
    LAS unsigned char* p = buf + VT_OFF + ((tid & 7) * 8) * VT_STRIDE + pos * 2;
#pragma unroll
    for (int i = 0; i < 2; ++i) {
        const u32x4 va = vr[i * 2], vb = vr[i * 2 + 1];
#pragma unroll
        for (int e2 = 0; e2 < 4; ++e2) {
            *(LAS unsigned*)(p + i * 256 + (2 * e2) * VT_STRIDE) = (va[e2] & 0xffffu) | (vb[e2] << 16);
            *(LAS unsigned*)(p + i * 256 + (2 * e2 + 1) * VT_STRIDE) = (va[e2] >> 16) | (vb[e2] & 0xffff0000u);
        }
    }
}
__device__ __forceinline__ void attn_load_q(const bf16_t* QB, int it, int wid, int sb, int r, int h, bf16x8 (&qf)[4]) {
    const int kvh = it & 3, blk = (it >> 2) & 63, b = it >> 8, t0 = b * SEQ_ + blk * 128, a0 = (wid & 1) * 64 + sb * 32, hq = kvh * 4 + (wid >> 1);
    const bf16_t* qp = QB + (size_t)(t0 + a0 + r) * D_ + hq * 64 + 8 * h;
#pragma unroll
    for (int kk = 0; kk < 4; ++kk) qf[kk] = *(const bf16x8*)(qp + 16 * kk);
}
__device__ __forceinline__ void attn_sub(const LAS unsigned char* buf, const bf16x8 (&qf)[4], const bf16_t* ZB, bf16_t* OG, int t0, int a0, int blk, int hq, float sink2, int r, int h) {
    const int kt0 = a0 >> 5;
    const size_t rowoff = (size_t)(t0 + a0 + r) * D_ + hq * 64;
    u32x4 zq[2][2];
#pragma unroll
    for (int db = 0; db < 2; ++db)
#pragma unroll
        for (int pr = 0; pr < 2; ++pr) zq[db][pr] = *(const u32x4*)(ZB + rowoff + 32 * db + 16 * pr + 8 * h);
    f32x16 S[5];
#pragma unroll
    for (int t = 0; t < 5; ++t) {
#pragma unroll
        for (int i = 0; i < 16; ++i) S[t][i] = 0.f;
#pragma unroll
        for (int kk = 0; kk < 4; ++kk) { const bf16x8 kf = *(const LAS bf16x8*)(buf + (32 * (kt0 + t) + r) * KS_STRIDE + (16 * kk + 8 * h) * 2); S[t] = __builtin_amdgcn_mfma_f32_32x32x16_bf16(kf, qf[kk], S[t], 0, 0, 0); }
    }
    const int rr = r - 4 * h;
#pragma unroll
    for (int i = 0; i < 16; ++i) { const int ci = (i & 3) + 8 * (i >> 2); S[0][i] = (ci > rr) ? S[0][i] : -1e30f; S[4][i] = (ci <= rr) ? S[4][i] : -1e30f; }
    if (blk == 0) {
#pragma unroll
        for (int t = 0; t < 4; ++t) if (kt0 + t < 4) {
#pragma unroll
            for (int i = 0; i < 16; ++i) S[t][i] = -1e30f; }
    }
    float mx = sink2;
#pragma unroll
    for (int t = 0; t < 5; ++t)
#pragma unroll
        for (int i = 0; i < 16; ++i) mx = fmaxf(mx, S[t][i]);
    { auto rr = __builtin_amdgcn_permlane32_swap(__float_as_uint(mx), __float_as_uint(mx), false, false); mx = fmaxf(__uint_as_float(rr[0]), __uint_as_float(rr[1])); }
    float sum = 0.f;
#pragma unroll
    for (int t = 0; t < 5; ++t)
#pragma unroll
        for (int i = 0; i < 16; ++i) { const float p = __builtin_amdgcn_exp2f(S[t][i] - mx); S[t][i] = p; sum += p; }
    { auto rr = __builtin_amdgcn_permlane32_swap(__float_as_uint(sum), __float_as_uint(sum), false, false); sum = __uint_as_float(rr[0]) + __uint_as_float(rr[1]); }
    sum += __builtin_amdgcn_exp2f(sink2 - mx);
    const float inv = __builtin_amdgcn_rcpf(sum);
    f32x16 O[2];
#pragma unroll
    for (int db = 0; db < 2; ++db)
#pragma unroll
        for (int i = 0; i < 16; ++i) O[db][i] = 0.f;
#pragma unroll
    for (int t = 0; t < 5; ++t)
#pragma unroll
        for (int s = 0; s < 2; ++s) {
            u32x4 pk; pk.x = cvt_pk_bf16(S[t][8 * s + 0], S[t][8 * s + 1]); pk.y = cvt_pk_bf16(S[t][8 * s + 2], S[t][8 * s + 3]); pk.z = cvt_pk_bf16(S[t][8 * s + 4], S[t][8 * s + 5]); pk.w = cvt_pk_bf16(S[t][8 * s + 6], S[t][8 * s + 7]);
            const bf16x8 pf = __builtin_bit_cast(bf16x8, pk);
#pragma unroll
            for (int db = 0; db < 2; ++db) { const bf16x8 vf = *(const LAS bf16x8*)(buf + VT_OFF + (32 * db + r) * VT_STRIDE + (32 * (kt0 + t) + 16 * s + 8 * h) * 2); O[db] = __builtin_amdgcn_mfma_f32_32x32x16_bf16(vf, pf, O[db], 0, 0, 0); }
        }
#pragma unroll
    for (int db = 0; db < 2; ++db)
#pragma unroll
        for (int pr = 0; pr < 2; ++pr) {
            u32x4 z4 = zq[db][pr];
            { auto r0 = __builtin_amdgcn_permlane32_swap(z4.x, z4.z, false, false); auto r1 = __builtin_amdgcn_permlane32_swap(z4.y, z4.w, false, false); z4.x = r0[0]; z4.z = r0[1]; z4.y = r1[0]; z4.w = r1[1]; }
            const int ia = 8 * pr, ib = 8 * pr + 4;
            unsigned a0 = cvt_pk_bf16(O[db][ia + 0] * inv * __uint_as_float(z4.x << 16), O[db][ia + 1] * inv * __uint_as_float(z4.x & 0xffff0000u));
            unsigned a1 = cvt_pk_bf16(O[db][ia + 2] * inv * __uint_as_float(z4.y << 16), O[db][ia + 3] * inv * __uint_as_float(z4.y & 0xffff0000u));
            unsigned b0 = cvt_pk_bf16(O[db][ib + 0] * inv * __uint_as_float(z4.z << 16), O[db][ib + 1] * inv * __uint_as_float(z4.z & 0xffff0000u));
            unsigned b1 = cvt_pk_bf16(O[db][ib + 2] * inv * __uint_as_float(z4.w << 16), O[db][ib + 3] * inv * __uint_as_float(z4.w & 0xffff0000u));
            { auto r0 = __builtin_amdgcn_permlane32_swap(a0, b0, false, false); auto r1 = __builtin_amdgcn_permlane32_swap(a1, b1, false, false); a0 = r0[0]; b0 = r0[1]; a1 = r1[0]; b1 = r1[1]; }
            *(u32x4*)(OG + rowoff + 32 * db + 16 * pr + 8 * h) = (u32x4){a0, a1, b0, b1};
        }
}
__device__ __forceinline__ void attn_phase(const Args& a, LAS unsigned char* lds) {
    const int tid = threadIdx.x, wid = tid >> 6, lane = tid & 63, r = lane & 31, h = lane >> 5, G = gridDim.x;
    unsigned char* ws = a.ws;
    const bf16_t* KB = (const bf16_t*)(ws + WS_KB); const bf16_t* VB = (const bf16_t*)(ws + WS_VB); const bf16_t* QB = (const bf16_t*)(ws + WS_R1);
    const bf16_t* ZB = (const bf16_t*)(ws + WS_ZB); bf16_t* OG = (bf16_t*)(ws + WS_OG);
    u32x4 kr[4], vr[4];
    bf16x8 qa[4], qb[4];
    int it = blockIdx.x;
    if (it < 1024) { attn_load_k(KB, it, tid, kr); attn_load_v(VB, it, tid, vr); attn_load_q(QB, it, wid, 0, r, h, qa); attn_store_k(lds, tid, kr); attn_store_v(lds, tid, vr); }
    __syncthreads();
    for (int n = 0; it < 1024; it += G, ++n) {
        const LAS unsigned char* buf = lds + (n & 1) * ATT_BUF; LAS unsigned char* nbuf = lds + ((n + 1) & 1) * ATT_BUF;
        const int kvh = it & 3, blk = (it >> 2) & 63, b = it >> 8, t0 = b * SEQ_ + blk * 128;
        const bool hasn = (it + G) < 1024;
        if (hasn) attn_load_k(KB, it + G, tid, kr);
        attn_load_q(QB, it, wid, 1, r, h, qb);
        const int g = wid >> 1, hq = kvh * 4 + g; const float sink2 = a.sinks[hq] * 1.4426950408889634f;
        attn_sub(buf, qa, ZB, OG, t0, (wid & 1) * 64, blk, hq, sink2, r, h);
        if (hasn) { attn_store_k(nbuf, tid, kr); attn_load_v(VB, it + G, tid, vr); attn_load_q(QB, it + G, wid, 0, r, h, qa); }
        attn_sub(buf, qb, ZB, OG, t0, (wid & 1) * 64 + 32, blk, hq, sink2, r, h);
        if (hasn) attn_store_v(nbuf, tid, vr);
        __syncthreads();
    }
}

#define XB_TMO      128
#define XB_XCNT(j)  (256  + 64 * (j))
#define XB_XSUB(j)  (1280 + 64 * (j))
#define XB_XGEN(j)  (2304 + 64 * (j))
#define XB_TOP      3328
#define XB_TOPGEN   3392
#define XCD_BAR_WORDS 3456
#define XB_SPIN_CAP (1u << 18)
__device__ __forceinline__ unsigned xb_ld(unsigned* p)              { return __hip_atomic_load(p, __ATOMIC_RELAXED, __HIP_MEMORY_SCOPE_AGENT); }
__device__ __forceinline__ unsigned xb_add(unsigned* p, unsigned v) { return __hip_atomic_fetch_add(p, v, __ATOMIC_RELAXED, __HIP_MEMORY_SCOPE_AGENT); }
__device__ __forceinline__ unsigned xb_xcc_id() { return (unsigned)__builtin_amdgcn_s_getreg((3 << 11) | 20) & 0xFu; }
#define XB_SPIN(cond, bar) do { unsigned _sp = 0; while (cond) { __builtin_amdgcn_s_sleep(1); \
    if ((++_sp & 255u) == 0u) { if (xb_ld(&(bar)[XB_TMO])) break; if (_sp > XB_SPIN_CAP) { atomicAdd(&(bar)[XB_TMO], 1u); break; } } } } while (0)
struct XcdBarrier { unsigned* bar; unsigned x; volatile LAS unsigned* st; };
__device__ __forceinline__ XcdBarrier xcd_barrier_post(unsigned* bar, volatile LAS unsigned* st) {
    XcdBarrier b; b.bar = bar; b.x = xb_xcc_id(); b.st = st;
    if (threadIdx.x == 0) (void)xb_add(&bar[XB_XCNT(b.x)], 1u);
    return b;
}
__device__ __forceinline__ void xcd_barrier_complete(unsigned* bar, unsigned x, unsigned& nloc, unsigned& nx) {
    const unsigned G = gridDim.x * gridDim.y * gridDim.z;
    unsigned sum, cnt, mine, sp = 0u;
    for (;;) {
        sum = 0u; cnt = 0u; mine = 0u;
#pragma unroll
        for (unsigned j = 0; j < 16; ++j) { const unsigned c = xb_ld(&bar[XB_XCNT(j)]); sum += c; cnt += (c > 0u) ? 1u : 0u; mine = (j == x) ? c : mine; }
        if (sum == G) break;
        __builtin_amdgcn_s_sleep(1);
        if ((++sp & 255u) == 0u) { if (xb_ld(&bar[XB_TMO])) break; if (sp > XB_SPIN_CAP) { atomicAdd(&bar[XB_TMO], 1u); break; } }
    }
    nloc = mine > 0u ? mine : 1u; nx = cnt > 0u ? cnt : 1u;
}
__device__ __forceinline__ void xcd_barrier(const XcdBarrier& b) {
    asm volatile("s_waitcnt vmcnt(0)" ::: "memory");
    __syncthreads();
    if (threadIdx.x == 0) {
        unsigned* bar = b.bar;
        __builtin_amdgcn_s_waitcnt(0);
        unsigned nloc = b.st[0], nx = b.st[1];
        if (nloc == 0u) { xcd_barrier_complete(bar, b.x, nloc, nx); b.st[0] = nloc; b.st[1] = nx; }
        const unsigned old = xb_add(&bar[XB_XSUB(b.x)], 1u);
        const unsigned gen = old / nloc;
        if (old + 1u == (gen + 1u) * nloc) {
            __builtin_amdgcn_fence(__ATOMIC_RELEASE, "agent");
            asm volatile("s_waitcnt vmcnt(0)" ::: "memory");
            const unsigned og = xb_add(&bar[XB_TOP], 1u);
            const unsigned tg = og / nx;
            if (og + 1u == (tg + 1u) * nx) xb_add(&bar[XB_TOPGEN], 1u);
            else XB_SPIN(xb_ld(&bar[XB_TOPGEN]) == tg, bar);
            __builtin_amdgcn_fence(__ATOMIC_ACQUIRE, "agent");
            xb_add(&bar[XB_XGEN(b.x)], 1u);
            asm volatile("s_waitcnt vmcnt(0)" ::: "memory");
        } else {
            XB_SPIN(xb_ld(&bar[XB_XGEN(b.x)]) == gen, bar);
            __builtin_amdgcn_fence(__ATOMIC_ACQUIRE, "agent");
            asm volatile("s_waitcnt vmcnt(0)" ::: "memory");
        }
    }
    __syncthreads();
}

__global__ void __launch_bounds__(512, 2) fwd(Args a) {
    extern __shared__ __attribute__((aligned(16))) unsigned char lds_raw[];
    LAS unsigned char* lds = (LAS unsigned char*)lds_raw;
    unsigned char* ws = a.ws;
    const int G = gridDim.x;
    bf16_t* WT = (bf16_t*)(ws + WS_WT);
#if MEGA
    cg::grid_group grid = cg::this_grid();
    unsigned* barw = (unsigned*)(ws + WS_BAR);
    volatile LAS unsigned* xst = (volatile LAS unsigned*)(lds + XBST_OFF);
    if (threadIdx.x < 4) xst[threadIdx.x] = 0u;
    __syncthreads();
    XcdBarrier xb = xcd_barrier_post(barw, xst);
    if (a.lo < 0) grid.sync();
#define SEAM0() xcd_barrier(xb)
#define SEAM() xcd_barrier(xb)
#else
#define SEAM0() do {} while (0)
#define SEAM() do {} while (0)
#endif
#define IN(k) (a.lo <= (k) && (k) < a.hi)
    if (IN(0)) phase0(a, lds);
    if (IN(0) && IN(1)) SEAM0();
    if (IN(1)) {
        Gemm g{(const bf16_t*)(ws + WS_R0), WT + (size_t)WROW1 * D_, M_, 4096, D_}; StaticOrder S; S.init(M_, 4096, G, (int)blockIdx.x);
        for (int i = threadIdx.x; i < 768; i += 512) *(LAS f32x4*)(lds + ROPER_OFF + i * 16) = *(const f32x4*)(a.conv_a + i * 4);
        __syncthreads();
        Epi1 E{(bf16_t*)(ws + WS_R1), (const LAS float*)(lds + ROPER_OFF), (float*)(ws + WS_VL), (float*)(ws + WS_G), (float*)(ws + WS_YP), (LAS float*)(lds + HALO_OFF)};
        gemm_phase<Epi1>(lds, g, S, E);
    }
    if (IN(1) && IN(2)) SEAM();
    if (IN(2)) {
        StaticOrder S; S.init(M_, 1024, G, (int)blockIdx.x);
        { Unit u; for (int i = 0; S.next(i, u); ++i) patch_y(a, u.pm); }
        { LAS float* it = (LAS float*)(lds + RSTD_OFF); const float* rs0 = (const float*)(ws + WS_RSTD0);
          Unit u; for (int i = 0; i < 8 && S.next(i, u); ++i) if (threadIdx.x < 256) it[i * 256 + threadIdx.x] = rs0[u.pm * BM + threadIdx.x];
          LAS float* ig = (LAS float*)(lds + ROPER_OFF);
          for (int i = threadIdx.x; i < D_; i += 512) ig[i] = 1.0f / a.ln_a[i]; }
        asm volatile("s_waitcnt vmcnt(0)" ::: "memory"); __syncthreads();
        Gemm g{(const bf16_t*)(ws + WS_R1), WT + (size_t)WROW2 * D_, M_, 1024, D_};
        Epi2 E{(bf16_t*)(ws + WS_R0), (float*)(ws + WS_SSQ), (const LAS float*)(lds + RSTD_OFF), (const LAS float*)(lds + ROPER_OFF)};
        gemm_phase<Epi2>(lds, g, S, E);
    }
    if (IN(2) && IN(3)) SEAM();
    if (IN(3)) {
        Gemm g{(const bf16_t*)(ws + WS_R0), WT + (size_t)WROW3 * D_, M_, 2560, D_}; StaticOrder S; S.init(M_, 2560, G, (int)blockIdx.x);
        { LAS float* rt = (LAS float*)(lds + RSTD_OFF); const float* SSQ = (const float*)(ws + WS_SSQ);
          Unit u; for (int i = 0; i < 8 && S.next(i, u); ++i)
              if (threadIdx.x < 256) { const f32x4* sp = (const f32x4*)(SSQ + (size_t)(u.pm * BM + threadIdx.x) * 16); const f32x4 s0 = sp[0], s1 = sp[1], s2 = sp[2], s3 = sp[3];
                  const float tot = ((s0[0] + s0[1]) + (s0[2] + s0[3])) + ((s1[0] + s1[1]) + (s1[2] + s1[3])) + ((s2[0] + s2[1]) + (s2[2] + s2[3])) + ((s3[0] + s3[1]) + (s3[2] + s3[3]));
                  rt[i * 256 + threadIdx.x] = rsqrtf(tot * (1.0f / 1024.0f) + EPS_); }
          const float* ropeG = (const float*)(ws + WS_ROPE);
          for (int i = threadIdx.x; i < 1024; i += 512) *(LAS f32x4*)(lds + ROPER_OFF + i * 16) = *(const f32x4*)(ropeG + i * 4);
          if (threadIdx.x < 128) ((LAS float*)(lds + GAIN_OFF))[threadIdx.x] = (threadIdx.x < 64) ? a.k_norm[threadIdx.x] : a.q_norm[threadIdx.x - 64];
          __syncthreads(); }
        Epi3 E{(const LAS float*)(lds + RSTD_OFF), (const LAS float*)(lds + ROPER_OFF), (const LAS float*)(lds + GAIN_OFF), (const float*)(ws + WS_ROPE) + 256 * 16, (bf16_t*)(ws + WS_KB), (bf16_t*)(ws + WS_VB), (bf16_t*)(ws + WS_R1), (bf16_t*)(ws + WS_ZB)};
        gemm_phase<Epi3>(lds, g, S, E);
    }
    if (IN(3) && IN(4)) SEAM();
    if (IN(4)) attn_phase(a, lds);
    if (IN(4) && IN(5)) SEAM();
    if (IN(5)) {
        Gemm g{(const bf16_t*)(ws + WS_OG), WT + (size_t)WROW4 * D_, M_, 1024, D_}; StaticOrder S; S.init(M_, 1024, G, (int)blockIdx.x);
        Epi4 E{(const bf16_t*)(ws + WS_R0), a.out};
        gemm_phase<Epi4>(lds, g, S, E);
    }
}

extern "C" void kernel_launch(void* const* d_in, const int* in_sizes, int n_in, void* d_out, int out_size, void* d_ws, size_t ws_size, hipStream_t stream) {
    static int grid = 0;
    if (grid == 0) {
        if (n_in != 13 || out_size != M_ * D_ || ws_size < WS_END) { fprintf(stderr, "kernel_launch: unexpected shapes (n_in %d out %d ws %zu)\n", n_in, out_size, ws_size); grid = -1; return; }
        int dev = 0, cus = 0, per_cu = 0;
        (void)hipGetDevice(&dev); (void)hipDeviceGetAttribute(&cus, hipDeviceAttributeMultiprocessorCount, dev);
        if (hipFuncSetAttribute((const void*)fwd, hipFuncAttributeMaxDynamicSharedMemorySize, LDS_BYTES) != hipSuccess) { fprintf(stderr, "kernel_launch: hipFuncSetAttribute failed\n"); grid = -1; return; }
        if (hipOccupancyMaxActiveBlocksPerMultiprocessor(&per_cu, (const void*)fwd, 512, LDS_BYTES) != hipSuccess || per_cu < 1) { fprintf(stderr, "kernel_launch: occupancy query failed (%d)\n", per_cu); (void)hipGetLastError(); per_cu = 1; }
        grid = cus * 1;
        (void)per_cu;
    }
    if (grid < 0) return;
    Args a{};
    a.x = (const float*)d_in[0]; a.ln_a = (const float*)d_in[1]; a.w_in_a = (const float*)d_in[2]; a.conv_a = (const float*)d_in[3]; a.w_out_a = (const float*)d_in[4];
    a.ln_kv = (const float*)d_in[5]; a.w_kv = (const float*)d_in[6]; a.k_norm = (const float*)d_in[7]; a.ln_b = (const float*)d_in[8]; a.w_in_b = (const float*)d_in[9];
    a.q_norm = (const float*)d_in[10]; a.sinks = (const float*)d_in[11]; a.w_out_b = (const float*)d_in[12];
    a.out = (float*)d_out; a.ws = (unsigned char*)d_ws + ((ws_size - WS_END) & ~(size_t)0xFFFFF);
    { float iv[8]; for (int i = 0; i < 8; ++i) iv[i] = (float)std::pow(500000.0, -(double)i / 8.0);
      a.inv0 = iv[0]; a.inv1 = iv[1]; a.inv2 = iv[2]; a.inv3 = iv[3]; a.inv4 = iv[4]; a.inv5 = iv[5]; a.inv6 = iv[6]; a.inv7 = iv[7]; }
#if MEGA
    a.lo = 0; a.hi = 6;
    if (hipMemsetAsync((char*)a.ws + WS_BAR, 0, XCD_BAR_WORDS * 4, stream) != hipSuccess) { fprintf(stderr, "kernel_launch: memset of barrier words failed\n"); return; }
    void* args[] = {&a};
    hipError_t e = hipLaunchCooperativeKernel((const void*)fwd, dim3(grid), dim3(512), args, LDS_BYTES, stream);
    if (e != hipSuccess) fprintf(stderr, "cooperative launch failed: %s (grid %d)\n", hipGetErrorString(e), grid);
#else
    for (int p = 0; p < 6; ++p) { a.lo = p; a.hi = p + 1; hipLaunchKernelGGL(fwd, dim3(grid), dim3(512), LDS_BYTES, stream, a); }
#endif
}
```
